# Optimizing an MI355X kernel written in HIP

```python
import jax
import jax.numpy as jnp
from jax import lax
import numpy as np

D_MODEL = 1024
BATCH = 8
SEQ = 2048
DEPTH = 4

CHUNK = 64
N_META = 16
NORM_EPS = 1e-6
D_MIX = D_MODEL

A_WIDTH = 3 * D_MODEL // 8
A_HEADS = 6
A_HEAD = A_WIDTH // A_HEADS
A_CONV = 4
A_C = 8.0
A_MIN_RAD = 0.9
A_MAX_RAD = 0.999

B_WIDTH = 3 * D_MODEL // 8
B_HEAD = 64
B_HEADS = B_WIDTH // B_HEAD
B_LORA_W = 32
B_LORA_A = 32
B_LORA_V = 16
B_LORA_G = 64
B_GN_EPS = 64e-5

C_WIDTH = D_MIX - A_WIDTH - B_WIDTH
C_HEADS = 4
C_HEAD_K = C_WIDTH // C_HEADS
C_HEAD_V = C_WIDTH // C_HEADS

A_COLS = 2 * A_WIDTH
B_COLS = 3 * B_WIDTH + B_LORA_W + B_LORA_A + B_LORA_G
C_COLS = 4 * C_WIDTH
N_IN = A_COLS + B_COLS + C_COLS
D_FF = 4 * D_MODEL

kernel_name = "hymba_style_rglru_rwkv7_hgrn2_trunk"

F32 = jnp.float32


def _split(t, sizes):
    return jnp.split(t, np.cumsum(sizes)[:-1].tolist(), axis=-1)


def rmsnorm(x, g, eps=NORM_EPS):
    xf = x.astype(F32)
    y = xf * lax.rsqrt(jnp.mean(xf * xf, axis=-1, keepdims=True) + eps)
    return (y * g.astype(F32)).astype(x.dtype)


def token_shift(p, mu):
    prev = jnp.pad(p, ((0, 0), (1, 0), (0, 0)))[:, :-1]
    return p + mu * (prev - p)


def causal_depthwise_conv(x, w, b):
    k_width, ch = w.shape
    y = lax.conv_general_dilated(x, w[:, None, :].astype(x.dtype), window_strides=(1,),
                                 padding=[(k_width - 1, 0)],
                                 dimension_numbers=('NWC', 'WIO', 'NWC'),
                                 feature_group_count=ch)
    return y + b


def rg_lru_group(xa, gate, conv_w, conv_b, w_r, b_r, w_i, b_i, lam):
    bn, L, _ = xa.shape
    u = causal_depthwise_conv(xa.astype(F32), conv_w.astype(F32), conv_b).astype(F32)
    uh = u.reshape(bn, L, A_HEADS, A_HEAD)
    r = jax.nn.sigmoid(jnp.einsum('blhi,hij->blhj', uh, w_r).reshape(bn, L, A_WIDTH) + b_r)
    i = jax.nn.sigmoid(jnp.einsum('blhi,hij->blhj', uh, w_i).reshape(bn, L, A_WIDTH) + b_i)
    log_a = -A_C * r * jax.nn.softplus(-lam)
    a = jnp.exp(log_a)
    drive = jnp.sqrt(-jnp.expm1(2.0 * log_a)) * (i * u)

    def combine(left, right):
        a_l, b_l = left
        a_r, b_rr = right
        return a_l * a_r, a_r * b_l + b_rr

    _, h = lax.associative_scan(combine, (a, drive), axis=1)
    return h * jax.nn.gelu(gate.astype(F32), approximate=True)


def rwkv7_scan(r, decay, k, v, kk, aa):
    bn, L, H, N = r.shape

    def step(S, inp):
        r_t, w_t, k_t, v_t, kk_t, a_t = inp
        sa = jnp.einsum('bhvk,bhk->bhv', S, -kk_t)
        S = (S * w_t[:, :, None, :] + sa[..., None] * (kk_t * a_t)[:, :, None, :]
             + v_t[..., None] * k_t[:, :, None, :])
        return S, jnp.einsum('bhvk,bhk->bhv', S, r_t)

    xs = tuple(jnp.moveaxis(t, 1, 0) for t in (r, decay, k, v, kk, aa))
    _, y = lax.scan(step, jnp.zeros((bn, H, N, N), F32), xs)
    return jnp.moveaxis(y, 0, 1)


def rwkv7_group(p, mu, w0, w2, a0, a2, g2, k_k, k_a, r_k, ln_g, ln_b, v_first, v0, v1, v2):
    bn, L, _ = p.shape
    p = token_shift(p.astype(F32), mu)
    r, k, v, wd, ad, gd = _split(p, [B_WIDTH, B_WIDTH, B_WIDTH, B_LORA_W, B_LORA_A, B_LORA_G])
    w_log = -jax.nn.softplus(-(w0 + jnp.tanh(wd) @ w2)) - 0.5
    decay = jnp.exp(-jnp.exp(w_log))
    if v_first is None:
        v_first = v
    else:
        v = v + (v_first - v) * jax.nn.sigmoid(v0 + (v @ v1) @ v2)
    aa = jax.nn.sigmoid(a0 + ad @ a2)
    g = jax.nn.sigmoid(gd) @ g2

    def heads(t):
        return t.reshape(bn, L, B_HEADS, B_HEAD)

    kk = heads(k * k_k)
    kk = kk / jnp.maximum(jnp.sqrt(jnp.sum(kk * kk, axis=-1, keepdims=True)), 1e-12)
    k = k * (1.0 + (aa - 1.0) * k_a)
    rh, kh, vh, ah = heads(r), heads(k), heads(v), heads(aa)
    y = rwkv7_scan(rh, heads(decay), kh, vh, kk, ah)
    mean = jnp.mean(y, axis=-1, keepdims=True)
    var = jnp.mean(jnp.square(y - mean), axis=-1, keepdims=True)
    y = ((y - mean) * lax.rsqrt(var + B_GN_EPS)).reshape(bn, L, B_WIDTH) * ln_g + ln_b
    y = y + (jnp.sum(rh * kh * r_k, axis=-1, keepdims=True) * vh).reshape(bn, L, B_WIDTH)
    return y * g, v_first


def hgrn2_chunked(q, k, v, logf):
    bn, L, H, dk = q.shape
    dv = v.shape[-1]
    n = L // CHUNK

    def to_chunks(t):
        return jnp.moveaxis(t.reshape(bn, n, CHUNK, H, t.shape[-1]), 1, 0)

    causal = jnp.tril(jnp.ones((CHUNK, CHUNK), bool))[None, :, :, None, None]

    def step(S, inp):
        qc, kc, vc, gc = inp
        b = jnp.cumsum(gc, axis=1)
        o_inter = jnp.einsum('bthk,bhkv->bthv', qc * jnp.exp(b), S)
        diff = b[:, :, None] - b[:, None, :]
        dec = jnp.exp(jnp.where(causal, diff, -jnp.inf))
        att = jnp.einsum('bthk,bshk,btshk->bhts', qc, kc, dec)
        o_intra = jnp.einsum('bhts,bshv->bthv', att, vc)
        b_last = b[:, -1]
        S = S * jnp.exp(b_last)[..., None] + jnp.einsum(
            'bshk,bshv->bhkv', kc * jnp.exp(b_last[:, None] - b), vc)
        return S, o_inter + o_intra

    xs = (to_chunks(q), to_chunks(k), to_chunks(v), to_chunks(logf))
    _, o = lax.scan(step, jnp.zeros((bn, H, dk, dv), F32), xs)
    return jnp.moveaxis(o, 0, 1).reshape(bn, L, H, dv)


def hgrn2_group(p, lb, norm_g):
    bn, L, _ = p.shape
    q, fz, i, og = _split(p.astype(F32), [C_WIDTH, C_WIDTH, C_WIDTH, C_WIDTH])
    f = lb + (1.0 - lb) * jax.nn.sigmoid(fz)
    logf = jnp.log(f)
    k = 1.0 - f
    q = jax.nn.silu(q)
    pad = (-L) % CHUNK

    def prep(t, d):
        return jnp.pad(t.reshape(bn, L, C_HEADS, d), ((0, 0), (pad, 0), (0, 0), (0, 0)))

    o = hgrn2_chunked(prep(q, C_HEAD_K), prep(k, C_HEAD_K), prep(i, C_HEAD_V),
                      prep(logf, C_HEAD_K))[:, pad:]
    o = o * lax.rsqrt(jnp.mean(o * o, axis=-1, keepdims=True) + NORM_EPS) * norm_g
    return o.reshape(bn, L, C_WIDTH) * jax.nn.silu(og)


def setup_inputs(seed: int = 0) -> dict:
    key = jax.random.key(seed)
    ks = iter(jax.random.split(key, 40))

    def nrm(shape, s):
        return s * jax.random.normal(next(ks), shape, F32)

    def unif(shape, lo, hi):
        return jax.random.uniform(next(ks), shape, F32, lo, hi)

    x = nrm((BATCH, SEQ, D_MODEL), 1.0)
    meta = nrm((N_META, D_MODEL), 1.0)
    mix_norm = 1.0 + nrm((DEPTH, D_MODEL), 0.02)
    w_in = nrm((DEPTH, D_MODEL, N_IN), D_MODEL ** -0.5)
    a_conv_w = nrm((DEPTH, A_CONV, A_WIDTH), A_CONV ** -0.5)
    a_conv_b = nrm((DEPTH, A_WIDTH), 0.02)
    a_w_r = nrm((DEPTH, A_HEADS, A_HEAD, A_HEAD), A_HEAD ** -0.5)
    a_b_r = nrm((DEPTH, A_WIDTH), 0.02)
    a_w_i = nrm((DEPTH, A_HEADS, A_HEAD, A_HEAD), A_HEAD ** -0.5)
    a_b_i = nrm((DEPTH, A_WIDTH), 0.02)
    a_pow = unif((DEPTH, A_WIDTH), A_MIN_RAD, A_MAX_RAD)
    a_rad = a_pow ** (1.0 / A_C)
    a_lambda = jnp.log(a_rad) - jnp.log1p(-a_rad)
    b_mu = unif((DEPTH, B_COLS), 0.2, 0.8)
    b_w0 = unif((DEPTH, B_WIDTH), -5.0, -1.0)
    b_w2 = nrm((DEPTH, B_LORA_W, B_WIDTH), 0.1)
    b_a0 = nrm((DEPTH, B_WIDTH), 0.1)
    b_a2 = nrm((DEPTH, B_LORA_A, B_WIDTH), B_LORA_A ** -0.5)
    b_g2 = nrm((DEPTH, B_LORA_G, B_WIDTH), B_LORA_G ** -0.5)
    b_k_k = 0.85 + nrm((DEPTH, B_WIDTH), 0.02)
    b_k_a = 1.0 + nrm((DEPTH, B_WIDTH), 0.02)
    b_r_k = nrm((DEPTH, B_HEADS, B_HEAD), 0.1)
    b_ln_g = 1.0 + nrm((DEPTH, B_WIDTH), 0.02)
    b_ln_b = nrm((DEPTH, B_WIDTH), 0.02)
    b_v0 = nrm((DEPTH - 1, B_WIDTH), 0.1)
    b_v1 = nrm((DEPTH - 1, B_WIDTH, B_LORA_V), B_WIDTH ** -0.5)
    b_v2 = nrm((DEPTH - 1, B_LORA_V, B_WIDTH), B_LORA_V ** -0.5)
    c_lb = nrm((DEPTH, C_WIDTH), 0.5)
    c_norm = 1.0 + nrm((DEPTH, C_HEAD_V), 0.02)
    w_out = nrm((DEPTH, D_MIX, D_MODEL), D_MIX ** -0.5)
    ffn_norm = 1.0 + nrm((DEPTH, D_MODEL), 0.02)
    w_up = nrm((DEPTH, D_MODEL, D_FF), D_MODEL ** -0.5)
    w_down = nrm((DEPTH, D_FF, D_MODEL), D_FF ** -0.5)
    final_norm = 1.0 + nrm((D_MODEL,), 0.02)
    return {"x": x, "meta": meta, "mix_norm": mix_norm, "w_in": w_in,
            "a_conv_w": a_conv_w, "a_conv_b": a_conv_b, "a_w_r": a_w_r, "a_b_r": a_b_r,
            "a_w_i": a_w_i, "a_b_i": a_b_i, "a_lambda": a_lambda,
            "b_mu": b_mu, "b_w0": b_w0, "b_w2": b_w2, "b_a0": b_a0, "b_a2": b_a2,
            "b_g2": b_g2, "b_k_k": b_k_k, "b_k_a": b_k_a, "b_r_k": b_r_k,
            "b_ln_g": b_ln_g, "b_ln_b": b_ln_b, "b_v0": b_v0, "b_v1": b_v1, "b_v2": b_v2,
            "c_lb": c_lb, "c_norm": c_norm, "w_out": w_out, "ffn_norm": ffn_norm,
            "w_up": w_up, "w_down": w_down, "final_norm": final_norm}


def reference(x, meta, mix_norm, w_in, a_conv_w, a_conv_b, a_w_r, a_b_r, a_w_i, a_b_i, a_lambda,
              b_mu, b_w0, b_w2, b_a0, b_a2, b_g2, b_k_k, b_k_a, b_r_k, b_ln_g, b_ln_b,
              b_v0, b_v1, b_v2, c_lb, c_norm, w_out, ffn_norm, w_up, w_down, final_norm):
    bn = x.shape[0]
    dt = x.dtype
    h = jnp.concatenate([jnp.broadcast_to(meta[None].astype(dt), (bn, N_META, D_MODEL)), x], axis=1)
    lb_all = jnp.cumsum(jax.nn.softmax(c_lb.astype(F32), axis=0), axis=0)
    lb_all = lb_all - lb_all[0]
    v_first = None
    for l in range(DEPTH):
        hn = rmsnorm(h, mix_norm[l])
        proj = jnp.einsum('bld,dn->bln', hn, w_in[l])
        pa, pb, pc = _split(proj, [A_COLS, B_COLS, C_COLS])
        xa, ga = _split(pa, [A_WIDTH, A_WIDTH])
        y_a = rg_lru_group(xa, ga, a_conv_w[l], a_conv_b[l], a_w_r[l], a_b_r[l],
                           a_w_i[l], a_b_i[l], a_lambda[l])
        if l == 0:
            v0, v1, v2 = None, None, None
        else:
            v0, v1, v2 = b_v0[l - 1], b_v1[l - 1], b_v2[l - 1]
        y_b, v_first = rwkv7_group(pb, b_mu[l], b_w0[l], b_w2[l], b_a0[l], b_a2[l], b_g2[l],
                                   b_k_k[l], b_k_a[l], b_r_k[l], b_ln_g[l], b_ln_b[l],
                                   v_first, v0, v1, v2)
        y_c = hgrn2_group(pc, lb_all[l], c_norm[l])
        y = jnp.concatenate([y_a, y_b, y_c], axis=-1).astype(dt)
        h = (h + jnp.einsum('bln,nd->bld', y, w_out[l])).astype(dt)
        hn = rmsnorm(h, ffn_norm[l])
        u = jnp.einsum('bld,df->blf', hn, w_up[l])
        h = (h + jnp.einsum('blf,fd->bld', jnp.square(jax.nn.relu(u)), w_down[l])).astype(dt)
    return rmsnorm(h, final_norm)[:, N_META:]
```

```cpp
#include <hip/hip_runtime.h>
#include <hip/hip_cooperative_groups.h>
#include <cstdio>
namespace cg = cooperative_groups;

#define LAS __attribute__((address_space(3)))
typedef unsigned short bf16_t;
typedef short bf16x8 __attribute__((ext_vector_type(8)));
typedef float f32x4 __attribute__((ext_vector_type(4)));
typedef float f32x2 __attribute__((ext_vector_type(2)));
typedef unsigned u32x4 __attribute__((ext_vector_type(4)));
typedef unsigned u32x2 __attribute__((ext_vector_type(2)));

constexpr int D = 1024, NBATCH = 8, SEQ = 2048, NMETA = 16, LTOK = SEQ + NMETA, MROWS = NBATCH * SEQ, RROWS = MROWS + NMETA, DEPTH = 4;
constexpr int NIN = 3072, DFF = 4096, BCOLS = 1280;
constexpr int LDS_BYTES = 131072, NTHREADS = 512;
constexpr int PC_XA = 0, PC_GA = 384, PC_B = 768, PC_Q = 2048, PC_FZ = 2304, PC_I = 2560, PC_OG = 2816;
constexpr int PC_YA = 0, PC_YB = 384, PC_YC = 768;
constexpr int ORAW_F = 576;

constexpr size_t WS_W0 = 0, WS_WSLOT = 8388608;
constexpr size_t WS_HB = 2 * WS_WSLOT;
constexpr size_t WS_PROJ = WS_HB + (size_t)RROWS * 1024 * 2;
constexpr size_t WS_PS = WS_PROJ + (size_t)RROWS * 3072 * 2;
constexpr size_t WS_PV = WS_PS + (size_t)RROWS * 6 * 320 * 2;
constexpr size_t WS_PG = WS_PV + (size_t)RROWS * 384 * 2;
constexpr size_t WS_VF = WS_PG + (size_t)RROWS * 384 * 2;
constexpr size_t WS_BONUS = WS_VF + (size_t)RROWS * 384 * 2;
constexpr size_t WS_SSQ = WS_BONUS + (size_t)RROWS * 8 * 4;
constexpr size_t WS_HMETA = WS_SSQ + (size_t)9 * RROWS * 8;
constexpr size_t WS_YMETA = WS_HMETA + (size_t)16 * 1024 * 4;
constexpr size_t WS_END = WS_YMETA + (size_t)16 * 1024 * 2;
static_assert((size_t)RROWS * 4096 * 2 <= WS_VF - WS_PROJ, "U must fit in PROJ..PG");
static_assert((size_t)RROWS * 384 * 4 <= (size_t)RROWS * 1024 * 2, "YRAW must fit in HB");
static_assert(WS_END <= 268435456ull, "workspace");

struct Params {
    const float *x, *meta, *mix_norm, *w_in, *a_conv_w, *a_conv_b, *a_w_r, *a_b_r, *a_w_i, *a_b_i, *a_lambda;
    const float *b_mu, *b_w0, *b_w2, *b_a0, *b_a2, *b_g2, *b_k_k, *b_k_a, *b_r_k, *b_ln_g, *b_ln_b, *b_v0, *b_v1, *b_v2;
    const float *c_lb, *c_norm, *w_out, *ffn_norm, *w_up, *w_down, *final_norm;
    float* out; unsigned char* ws;
    int ph_lo, ph_hi;
};

__device__ __forceinline__ int opaque_bid() { int t = blockIdx.x; asm volatile("" : "+s"(t)); return t; }
__device__ __forceinline__ int opaque_tid() { int t = threadIdx.x; asm volatile("" : "+v"(t)); return t; }
__device__ __forceinline__ unsigned cvt_pk_bf16(float lo, float hi) { unsigned r; asm volatile("v_cvt_pk_bf16_f32 %0, %1, %2" : "=v"(r) : "v"(lo), "v"(hi)); return r; }
__device__ __forceinline__ bf16_t f2bf(float f) { return (bf16_t)(cvt_pk_bf16(f, 0.f) & 0xffffu); }
__device__ __forceinline__ float bf2f(unsigned short b) { return __uint_as_float(((unsigned)b) << 16); }
__device__ __forceinline__ float bflo(unsigned u) { return __uint_as_float(u << 16); }
__device__ __forceinline__ float bfhi(unsigned u) { return __uint_as_float(u & 0xffff0000u); }
__device__ __forceinline__ float rcpf_(float x) { return __builtin_amdgcn_rcpf(x); }
__device__ __forceinline__ float sigmoidf_(float x) { return rcpf_(1.f + __expf(-x)); }
__device__ __forceinline__ float siluf_(float x) { return x * sigmoidf_(x); }
__device__ __forceinline__ float softplusf_(float x) { return fmaxf(x, 0.f) + log1pf(__expf(-fabsf(x))); }
__device__ __forceinline__ float tanhf_(float x) { const float e = __expf(-2.f * fabsf(x)); const float t = (1.f - e) * rcpf_(1.f + e); return x < 0.f ? -t : t; }
__device__ __forceinline__ float geluf_(float x) { return 0.5f * x * (1.f + tanhf_(0.7978845608028654f * (x + 0.044715f * x * x * x))); }

template <int CTRL> __device__ __forceinline__ float dppf(float x) { return __builtin_bit_cast(float, __builtin_amdgcn_update_dpp(0, __builtin_bit_cast(int, x), CTRL, 0xF, 0xF, true)); }
__device__ __forceinline__ float sum16(float x) {
    x += dppf<0xB1>(x); x += dppf<0x4E>(x); x += dppf<0x141>(x); x += dppf<0x140>(x); return x;
}
__device__ __forceinline__ float sum64(float x) {
    x = sum16(x);
    const int xi = __builtin_bit_cast(int, x);
    const float a = __builtin_bit_cast(float, __builtin_amdgcn_readlane(xi, 0)), b = __builtin_bit_cast(float, __builtin_amdgcn_readlane(xi, 16));
    const float c = __builtin_bit_cast(float, __builtin_amdgcn_readlane(xi, 32)), d = __builtin_bit_cast(float, __builtin_amdgcn_readlane(xi, 48));
    return (a + b) + (c + d);
}
__device__ __forceinline__ void unpack8(const u32x4 v, float* f) {
    f[0] = bflo(v.x); f[1] = bfhi(v.x); f[2] = bflo(v.y); f[3] = bfhi(v.y); f[4] = bflo(v.z); f[5] = bfhi(v.z); f[6] = bflo(v.w); f[7] = bfhi(v.w);
}
namespace pg8 {
#define PG8_LAS __attribute__((address_space(3)))
constexpr int BM = 256, BK = 64, HALF = 128, HTB = HALF * BK * 2  , STAGE_BYTES = 8 * HTB, NXCD = 8, WGM = 8;

__host__ __device__ __forceinline__ int lds_byte(int r, int c) { const int st = (r >> 4) * 2 + (c >> 5), rr = r & 15, cc = c & 31, ob = rr * 64 + cc * 2; return st * 1024 + (ob ^ (((ob >> 9) & 1) << 5)); }
__host__ __device__ __forceinline__ void stage_rc(int b, int& R, int& C) { const int st = b / 1024, sb = b % 1024, swz = sb ^ (((sb >> 9) & 1) << 5); R = (st >> 1) * 16 + swz / 64; C = (st & 1) * 32 + (swz % 64) / 2; }
__host__ __device__ __forceinline__ int perm32(int rho) { const int n = rho >> 4, i = rho & 15; return 8 * (i >> 2) + 4 * n + (i & 3); }

struct Unit { int pm, pn; };
struct Gemm { const bf16_t* A; const bf16_t* Bt; int M, N, K, lda; };

struct StaticOrder {
    int nM, nN, nwg, G, c;
    __host__ __device__ void init(int M, int N, int G_, int c_) { nM = M / BM; nN = N / BM; nwg = nM * nN; G = G_; c = c_; }
    __host__ __device__ bool next(int i, Unit& u) const {
        const long L = (long)i * G + c; if (L >= nwg) return false;
        int wgid = (int)L; { const int q = nwg / NXCD, r = nwg % NXCD, xcd = wgid % NXCD, off = wgid / NXCD; wgid = (xcd < r ? xcd * (q + 1) : r * (q + 1) + (xcd - r) * q) + off; }
        const int nig = WGM * nN, gid = wgid / nig, fm = gid * WGM, gsz = (nM - fm) < WGM ? (nM - fm) : WGM;
        u.pm = fm + ((wgid % nig) % gsz); u.pn = (wgid % nig) / gsz; return true;
    }
    __device__ __forceinline__ void a_ready(const Unit&) const {}
    __device__ __forceinline__ void done(const Unit&) const {}
};


template <class Epi, class Sched, bool AMAP>
__device__ __forceinline__ void gemm_phase(PG8_LAS unsigned char* lds, const Gemm g, const Sched& S, const Epi& E) {
    const int tid = opaque_tid(), wid = __builtin_amdgcn_readfirstlane(tid >> 6), lane = tid & 63, wr = wid >> 2, wc = wid & 3, fr = lane & 15, fq = lane >> 4;
    const int K = g.K, nt = K / BK;
    unsigned voffA[2], voffB[2];
#pragma unroll
    for (int i = 0; i < 2; ++i) { int R, C; stage_rc(tid * 16 + i * 8192, R, C); const int Rb = Epi::PERM ? ((R & ~31) + perm32(R & 31)) : R;
        voffA[i] = (unsigned)(R * g.lda + C) * 2u; voffB[i] = (unsigned)(Rb * K + C) * 2u; }
    const size_t kstep = (size_t)(BK * 2);
    const size_t hstep = (size_t)HALF * K * 2;
    const size_t tstep = 2 * hstep;
    const size_t hstepA = (size_t)HALF * g.lda * 2, tstepA = 2 * hstepA;
#define PG8_KOFS(t) ((size_t)(AMAP ? ((t) * 64 + ((t) >= 12 ? 1280 : ((t) >= 6 ? 384 : 0))) : (t) * 64) * 2)
    const unsigned ldsw = (unsigned)wid * 1024u;
    const int aoff = lds_byte(wr * 64 + fr, fq * 8), boff = lds_byte(wc * 32 + fr, fq * 8);
#define PG8_SA(b, h) (((b) * 2 + (h)) * HTB)
#define PG8_SB(b, h) ((4 + (b) * 2 + (h)) * HTB)
#define PG8_STAGE(bufoff, gbase, voff) do { _Pragma("unroll") for (int _i = 0; _i < 2; ++_i) \
        __builtin_amdgcn_global_load_lds((const unsigned*)((const char*)(gbase) + (voff)[_i]), (PG8_LAS unsigned*)(lds + (bufoff) + ldsw + _i * 8192), 16, 0, 0); } while (0)
#define PG8_LDA(dst, b, h) do { _Pragma("unroll") for (int m = 0; m < 4; ++m) _Pragma("unroll") for (int k = 0; k < 2; ++k) dst[m][k] = *(const PG8_LAS bf16x8*)(lds + PG8_SA(b, h) + aoff + m * 2048 + k * 1024); } while (0)
#define PG8_LDB(dst, b, h) do { _Pragma("unroll") for (int n = 0; n < 2; ++n) _Pragma("unroll") for (int k = 0; k < 2; ++k) dst[n][k] = *(const PG8_LAS bf16x8*)(lds + PG8_SB(b, h) + boff + n * 2048 + k * 1024); } while (0)
#define PG8_MMA(ai, bj, At, Bt) do { __builtin_amdgcn_s_setprio(1); _Pragma("unroll") for (int m = 0; m < 4; ++m) _Pragma("unroll") for (int n = 0; n < 2; ++n) _Pragma("unroll") for (int k = 0; k < 2; ++k) \
        acc[ai][bj][m][n] = __builtin_amdgcn_mfma_f32_16x16x32_bf16(Bt[n][k], At[m][k], acc[ai][bj][m][n], 0, 0, 0); __builtin_amdgcn_s_setprio(0); } while (0)
#define PG8_WAIT_V(n) asm volatile("s_waitcnt vmcnt(" #n ")" ::: "memory")
#define PG8_WAIT_L(n) asm volatile("s_waitcnt lgkmcnt(" #n ")" ::: "memory")
#define PG8_BAR __builtin_amdgcn_s_barrier()
#define PG8_SCHED __builtin_amdgcn_sched_barrier(0)
    Unit cur, nxt; int ui = 0;
    if (!S.next(0, cur)) return;
    f32x4 acc[2][2][4][2];
#pragma unroll
    for (int a = 0; a < 2; ++a)
#pragma unroll
        for (int b = 0; b < 2; ++b)
#pragma unroll
            for (int m = 0; m < 4; ++m)
#pragma unroll
                for (int n = 0; n < 2; ++n) acc[a][b][m][n] = (f32x4){0.f, 0.f, 0.f, 0.f};
    bf16x8 At[4][2], B0[2][2], B1[2][2];
    const char* cA = (const char*)g.A + (size_t)cur.pm * tstepA; const char* cB = (const char*)g.Bt + (size_t)cur.pn * tstep;
    S.a_ready(cur);
    PG8_STAGE(PG8_SB(0, 0), cB, voffB); PG8_STAGE(PG8_SA(0, 0), cA, voffA); PG8_STAGE(PG8_SB(0, 1), cB + hstep, voffB); PG8_STAGE(PG8_SA(0, 1), cA + hstepA, voffA);
    if (wr == 1) PG8_BAR;
    PG8_WAIT_V(4); PG8_BAR;
    PG8_STAGE(PG8_SB(1, 0), cB + kstep, voffB); PG8_STAGE(PG8_SA(1, 0), cA + PG8_KOFS(1), voffA); PG8_STAGE(PG8_SB(1, 1), cB + hstep + kstep, voffB);
    PG8_WAIT_V(6); PG8_BAR;
    for (;;) {
        const bool has_next = S.next(ui + 1, nxt);
        const char* nA = has_next ? (const char*)g.A + (size_t)nxt.pm * tstepA : cA; const char* nB = has_next ? (const char*)g.Bt + (size_t)nxt.pn * tstep : cB;
        for (int t = 0; t < nt; t += 2) {
            const bool last = (t == nt - 2);
            const char* a1 = cA + PG8_KOFS(t + 1);
            const char* a2 = last ? nA : cA + PG8_KOFS(t + 2); const char* b2 = last ? nB : cB + (size_t)(t + 2) * kstep;
            const char* a3 = last ? nA + PG8_KOFS(1) : cA + PG8_KOFS(t + 3); const char* b3 = b2 + kstep;
            if (last && has_next) S.a_ready(nxt);
            PG8_LDB(B0, 0, 0); PG8_SCHED; PG8_LDA(At, 0, 0); PG8_STAGE(PG8_SA(1, 1), a1 + hstepA, voffA);
            PG8_WAIT_L(8); PG8_BAR; PG8_WAIT_L(0); PG8_MMA(0, 0, At, B0); PG8_BAR; PG8_SCHED;
            PG8_LDB(B1, 0, 1); PG8_STAGE(PG8_SB(0, 0), b2, voffB);
            PG8_BAR; PG8_WAIT_L(0); PG8_MMA(0, 1, At, B1); PG8_BAR;
            PG8_LDA(At, 0, 1); PG8_STAGE(PG8_SA(0, 0), a2, voffA);
            PG8_BAR; PG8_WAIT_L(0); PG8_MMA(1, 0, At, B0); PG8_BAR; PG8_SCHED;
            PG8_STAGE(PG8_SB(0, 1), b2 + hstep, voffB);
            PG8_WAIT_V(6); PG8_BAR; PG8_MMA(1, 1, At, B1); PG8_BAR;
            PG8_LDB(B0, 1, 0); PG8_SCHED; PG8_LDA(At, 1, 0); PG8_STAGE(PG8_SA(0, 1), a2 + hstepA, voffA);
            PG8_WAIT_L(8); PG8_BAR; PG8_WAIT_L(0); PG8_MMA(0, 0, At, B0); PG8_BAR; PG8_SCHED;
            PG8_LDB(B1, 1, 1); PG8_STAGE(PG8_SB(1, 0), b3, voffB);
            PG8_BAR; PG8_WAIT_L(0); PG8_MMA(0, 1, At, B1); PG8_BAR;
            PG8_LDA(At, 1, 1); PG8_STAGE(PG8_SA(1, 0), a3, voffA);
            PG8_BAR; PG8_WAIT_L(0); PG8_MMA(1, 0, At, B0); PG8_BAR; PG8_SCHED;
            PG8_STAGE(PG8_SB(1, 1), b3 + hstep, voffB);
            PG8_WAIT_V(6); PG8_BAR; PG8_MMA(1, 1, At, B1); PG8_BAR;
        }
        if constexpr (!Epi::AFTER_DRAIN) { E(acc, cur, wr, wc, fr, fq); S.done(cur); }
        if (!has_next) break;
#pragma unroll
        for (int a = 0; a < 2; ++a)
#pragma unroll
            for (int b = 0; b < 2; ++b)
#pragma unroll
                for (int m = 0; m < 4; ++m)
#pragma unroll
                    for (int n = 0; n < 2; ++n) acc[a][b][m][n] = (f32x4){0.f, 0.f, 0.f, 0.f};
        cur = nxt; cA = nA; cB = nB; ++ui;
    }
    PG8_WAIT_V(0);
    if (wr == 0) PG8_BAR;
    PG8_BAR;
    if constexpr (Epi::AFTER_DRAIN) { E.fused(acc, cur, wr, wc, fr, fq, lds, wid, lane); S.done(cur); }
#undef PG8_SA
#undef PG8_KOFS
#undef PG8_SB
#undef PG8_STAGE
#undef PG8_LDA
#undef PG8_LDB
#undef PG8_MMA
#undef PG8_WAIT_V
#undef PG8_WAIT_L
#undef PG8_BAR
#undef PG8_SCHED
}
}

constexpr float SSQ_SCALE = 16777216.f, SSQ_INV = 1.f / (16777216.f * 1024.f);
template <int ACT  > struct EpScale {
    static constexpr bool PERM = false, AFTER_DRAIN = false;
    bf16_t* O; int ldo; const unsigned long long* ssq;
    __device__ __forceinline__ u32x2 pack(f32x4 v, float rs) const {
        v = v * rs;
        if (ACT == 1) { v.x = fmaxf(v.x, 0.f); v.y = fmaxf(v.y, 0.f); v.z = fmaxf(v.z, 0.f); v.w = fmaxf(v.w, 0.f); v = v * v; }
        u32x2 o; o.x = cvt_pk_bf16(v.x, v.y); o.y = cvt_pk_bf16(v.z, v.w); return o;
    }
    __device__ __forceinline__ void operator()(const f32x4 (&acc)[2][2][4][2], const pg8::Unit& u, int wr, int wc, int fr, int fq) const {
        const int row0 = u.pm * 256 + wr * 64 + fr, col0 = u.pn * 256 + wc * 32 + 4 * fq;
#pragma unroll
        for (int ai = 0; ai < 2; ++ai)
#pragma unroll
            for (int m = 0; m < 4; ++m) {
                const int row = row0 + ai * 128 + m * 16;
                const float rs = rsqrtf((float)ssq[row] * SSQ_INV + 1e-6f);
                bf16_t* rp = O + (size_t)row * ldo + col0;
#pragma unroll
                for (int bj = 0; bj < 2; ++bj)
#pragma unroll
                    for (int n = 0; n < 2; ++n) *(u32x2*)(rp + bj * 128 + n * 16) = pack(acc[ai][bj][m][n], rs);
                asm volatile("" ::: "memory");
            }
    }
    __device__ __forceinline__ void meta(int m, int col, f32x4 v) const {
        const int row = MROWS + m;
        const float rs = rsqrtf((float)ssq[row] * SSQ_INV + 1e-6f);
        *(u32x2*)(O + (size_t)row * ldo + col) = pack(v, rs);
    }
};
struct EpRes {
    static constexpr bool PERM = false, AFTER_DRAIN = false;
    const float* hres; float* hout; float* hmeta; bf16_t* hb; unsigned long long* ssq_out;
    __device__ __forceinline__ void operator()(const f32x4 (&acc)[2][2][4][2], const pg8::Unit& u, int wr, int wc, int fr, int fq) const {
        const int row0 = u.pm * 256 + wr * 64 + fr, col0 = u.pn * 256 + wc * 32 + 4 * fq;
#pragma unroll
        for (int ai = 0; ai < 2; ++ai)
#pragma unroll
            for (int m = 0; m < 4; ++m) {
                const int row = row0 + ai * 128 + m * 16;
                const size_t off = (size_t)row * 1024 + col0;
                float s = 0.f;
#pragma unroll
                for (int bj = 0; bj < 2; ++bj)
#pragma unroll
                    for (int n = 0; n < 2; ++n) {
                        const size_t o = off + bj * 128 + n * 16;
                        f32x4 h = *(const f32x4*)(hres + o) + acc[ai][bj][m][n];
                        *(f32x4*)(hout + o) = h;
                        u32x2 p; p.x = cvt_pk_bf16(h.x, h.y); p.y = cvt_pk_bf16(h.z, h.w);
                        *(u32x2*)(hb + o) = p;
                        s += (h.x * h.x + h.y * h.y) + (h.z * h.z + h.w * h.w);
                    }
                s += __shfl_xor(s, 16); s += __shfl_xor(s, 32);
                if (fq == 0) atomicAdd(ssq_out + row, __float2ull_rn(s * SSQ_SCALE));
                asm volatile("" ::: "memory");
            }
    }
    __device__ __forceinline__ void meta(int m, int col, f32x4 v) const {
        float* p = hmeta + m * 1024 + col;
        f32x4 h = *(const f32x4*)p + v;
        *(f32x4*)p = h;
        u32x2 q; q.x = cvt_pk_bf16(h.x, h.y); q.y = cvt_pk_bf16(h.z, h.w);
        *(u32x2*)(hb + (size_t)(MROWS + m) * 1024 + col) = q;
        atomicAdd(ssq_out + MROWS + m, __float2ull_rn(((h.x * h.x + h.y * h.y) + (h.z * h.z + h.w * h.w)) * SSQ_SCALE));
    }
};

template <class Epi>
__device__ __forceinline__ void meta_gemm(float* red  , const bf16_t* A, int lda, const bf16_t* Bt, int N, int K, const Epi& E) {
    const int tid = opaque_tid(), wid = tid >> 6, lane = tid & 63, i16 = lane & 15, quad = lane >> 4;
    const int kper = K / 8;
    for (int tile = opaque_bid(); tile < N / 16; tile += gridDim.x) {
        f32x4 acc = {0.f, 0.f, 0.f, 0.f};
        const bf16_t* ap = A + (size_t)i16 * lda + wid * kper + quad * 8;
        const bf16_t* bp = Bt + (size_t)(tile * 16 + i16) * K + wid * kper + quad * 8;
#pragma unroll 4
        for (int k = 0; k < kper; k += 32) {
            const bf16x8 a = *(const bf16x8*)(ap + k), b = *(const bf16x8*)(bp + k);
            acc = __builtin_amdgcn_mfma_f32_16x16x32_bf16(a, b, acc, 0, 0, 0);
        }
#pragma unroll
        for (int j = 0; j < 4; ++j) red[wid * 256 + (quad * 4 + j) * 16 + i16] = acc[j];
        __syncthreads();
        if (tid < 64) {
            const int row = tid >> 2, c4 = (tid & 3) * 4;
            f32x4 s = {0.f, 0.f, 0.f, 0.f};
#pragma unroll
            for (int w = 0; w < 8; ++w) s += *(const f32x4*)(red + w * 256 + row * 16 + c4);
            E.meta(row, tile * 16 + c4, s);
        }
        __syncthreads();
    }
}

__device__ __forceinline__ void conv_w(float* lds, const float* W, int K, int N, bf16_t* WT, const float* gain) {
    const int tid = opaque_tid(), wid = tid >> 6, lane = tid & 63;
    float* scr = lds + wid * (64 * 33);
    const int nblk = N / 32, nitems = (K / 64) * nblk;
    const int gw = opaque_bid() * 8 + wid, nw = gridDim.x * 8;
    for (int item = gw; item < nitems; item += nw) {
        const int kb = item / nblk, nb = item % nblk, k0 = 64 * kb, n0 = 32 * nb;
#pragma unroll 8
        for (int i = 0; i < 32; ++i) {
            const int kk = 2 * i + (lane >> 5);
            float v = W[(size_t)(k0 + kk) * N + n0 + (lane & 31)];
            if (gain) v *= gain[k0 + kk];
            scr[kk * 33 + (lane & 31)] = v;
        }
        __builtin_amdgcn_fence(__ATOMIC_RELEASE, "wavefront"); __builtin_amdgcn_wave_barrier(); __builtin_amdgcn_fence(__ATOMIC_ACQUIRE, "wavefront");
        const int c = lane & 7;
#pragma unroll
        for (int j = 0; j < 4; ++j) {
            const int n = (lane >> 3) + 8 * j; const float* s = scr + (8 * c) * 33 + n;
            u32x4 o; o.x = cvt_pk_bf16(s[0 * 33], s[1 * 33]); o.y = cvt_pk_bf16(s[2 * 33], s[3 * 33]); o.z = cvt_pk_bf16(s[4 * 33], s[5 * 33]); o.w = cvt_pk_bf16(s[6 * 33], s[7 * 33]);
            *(u32x4*)(WT + (size_t)(n0 + n) * K + k0 + 8 * c) = o;
        }
        __builtin_amdgcn_fence(__ATOMIC_RELEASE, "wavefront"); __builtin_amdgcn_wave_barrier(); __builtin_amdgcn_fence(__ATOMIC_ACQUIRE, "wavefront");
    }
}

__device__ __forceinline__ void phase_p0(const Params& p) {
    const int tid = opaque_tid(), wid = tid >> 6, lane = tid & 63;
    const int gw = opaque_bid() * 8 + wid, nw = gridDim.x * 8;
    bf16_t* hb = (bf16_t*)(p.ws + WS_HB); unsigned long long* ssq = (unsigned long long*)(p.ws + WS_SSQ); float* hmeta = (float*)(p.ws + WS_HMETA);
    for (int i = opaque_bid() * NTHREADS + tid; i < 8 * RROWS; i += gridDim.x * NTHREADS) ssq[RROWS + i] = 0ull;
    for (int row = gw; row < RROWS; row += nw) {
        const float* src = row < MROWS ? p.x + (size_t)row * 1024 : p.meta + (size_t)(row - MROWS) * 1024;
        float s = 0.f;
#pragma unroll
        for (int j = 0; j < 4; ++j) {
            const f32x4 v = *(const f32x4*)(src + j * 256 + lane * 4);
            s += (v.x * v.x + v.y * v.y) + (v.z * v.z + v.w * v.w);
            u32x2 q; q.x = cvt_pk_bf16(v.x, v.y); q.y = cvt_pk_bf16(v.z, v.w);
            *(u32x2*)(hb + (size_t)row * 1024 + j * 256 + lane * 4) = q;
            if (row >= MROWS) *(f32x4*)(hmeta + (size_t)(row - MROWS) * 1024 + j * 256 + lane * 4) = v;
        }
        s = sum64(s);
        if (lane == 0) ssq[row] = __float2ull_rn(s * SSQ_SCALE);
    }
}
__device__ __forceinline__ void phase_final(const Params& p) {
    const int tid = opaque_tid(), wid = tid >> 6, lane = tid & 63;
    const int gw = opaque_bid() * 8 + wid, nw = gridDim.x * 8;
    const unsigned long long* ssq = (const unsigned long long*)(p.ws + WS_SSQ) + (size_t)8 * RROWS;
    for (int row = gw; row < MROWS; row += nw) {
        const float rs = rsqrtf((float)ssq[row] * SSQ_INV + 1e-6f);
        float* o = p.out + (size_t)row * 1024;
#pragma unroll
        for (int j = 0; j < 4; ++j) {
            const f32x4 g = *(const f32x4*)(p.final_norm + j * 256 + lane * 4);
            f32x4 v = *(const f32x4*)(o + j * 256 + lane * 4);
            v = v * rs * g;
            *(f32x4*)(o + j * 256 + lane * 4) = v;
        }
    }
}
__device__ __forceinline__ void phase_prep(const Params& p, float* lds, int l) {
    const int tid = opaque_tid(), lane = tid & 63;
    float* ps = lds;
    float* as_ = lds + 16 * 1280;
    float* vlo = as_ + 16 * 384;
    float* as2 = as_;
    const bf16_t* proj = (const bf16_t*)(p.ws + WS_PROJ);
    bf16_t* PS = (bf16_t*)(p.ws + WS_PS); bf16_t* PV = (bf16_t*)(p.ws + WS_PV); bf16_t* PG = (bf16_t*)(p.ws + WS_PG); bf16_t* VF = (bf16_t*)(p.ws + WS_VF);
    float* BONUS = (float*)(p.ws + WS_BONUS);
    const float* mu = p.b_mu + l * BCOLS;
    const float* w2 = p.b_w2 + (size_t)l * 32 * 384; const float* a2 = p.b_a2 + (size_t)l * 32 * 384; const float* g2 = p.b_g2 + (size_t)l * 64 * 384;
    const float* v1 = l > 0 ? p.b_v1 + (size_t)(l - 1) * 384 * 16 : nullptr; const float* v2 = l > 0 ? p.b_v2 + (size_t)(l - 1) * 16 * 384 : nullptr;
    for (int tile = opaque_bid(); tile < 1025; tile += gridDim.x) {
        const int row0 = tile * 16;
        for (int q = tid; q < 2560; q += NTHREADS) {
            const int tok = q / 160, cc = (q % 160) * 8, row = row0 + tok;
            int prow;
            if (tile == 1024) prow = tok == 0 ? -1 : row - 1;
            else prow = (row & (SEQ - 1)) == 0 ? MROWS + NMETA - 1 : row - 1;
            const u32x4 cu = *(const u32x4*)(proj + (size_t)row * NIN + PC_B + cc);
            u32x4 pu = {0u, 0u, 0u, 0u};
            if (prow >= 0) pu = *(const u32x4*)(proj + (size_t)prow * NIN + PC_B + cc);
            float c[8], pv[8]; unpack8(cu, c); unpack8(pu, pv);
            const f32x4 m0 = *(const f32x4*)(mu + cc), m1 = *(const f32x4*)(mu + cc + 4);
            f32x4 o0, o1;
            o0.x = c[0] + m0.x * (pv[0] - c[0]); o0.y = c[1] + m0.y * (pv[1] - c[1]); o0.z = c[2] + m0.z * (pv[2] - c[2]); o0.w = c[3] + m0.w * (pv[3] - c[3]);
            o1.x = c[4] + m1.x * (pv[4] - c[4]); o1.y = c[5] + m1.y * (pv[5] - c[5]); o1.z = c[6] + m1.z * (pv[6] - c[6]); o1.w = c[7] + m1.w * (pv[7] - c[7]);
            *(f32x4*)(ps + tok * 1280 + cc) = o0; *(f32x4*)(ps + tok * 1280 + cc + 4) = o1;
        }
        __syncthreads();
        for (int q = tid; q < 16 * 128; q += NTHREADS) {
            const int tok = q >> 7, cl = 1152 + (q & 127);
            float v = ps[tok * 1280 + cl];
            if (cl < 1184) v = tanhf_(v); else if (cl >= 1216) v = sigmoidf_(v);
            ps[tok * 1280 + cl] = v;
        }
        if (l > 0 && tid < 256) {
            const int tok = tid >> 4, o = tid & 15;
            float acc = 0.f;
            const float* vp = ps + tok * 1280 + 768;
#pragma unroll 8
            for (int c = 0; c < 384; ++c) acc += vp[c] * v1[c * 16 + o];
            vlo[tok * 16 + o] = acc;
        }
        __syncthreads();
        if (tid < 384) {
            int c = tid; const int h = tid >> 6, j = lane;
#define OPQ_C() asm volatile("" : "+v"(c))
            {
                OPQ_C(); float wr_[32];
#pragma unroll
                for (int jj = 0; jj < 32; ++jj) wr_[jj] = a2[jj * 384 + c];
                const float a0 = p.b_a0[l * 384 + c];
#pragma unroll 1
                for (int tok = 0; tok < 16; ++tok) {
                    const float* ap = ps + tok * 1280 + 1184; float acc = a0;
#pragma unroll
                    for (int jj = 0; jj < 32; jj += 4) { const f32x4 t = *(const f32x4*)(ap + jj); acc += t.x * wr_[jj] + t.y * wr_[jj + 1] + t.z * wr_[jj + 2] + t.w * wr_[jj + 3]; }
                    as_[tok * 384 + c] = sigmoidf_(acc);
                }
            }
            {
                OPQ_C(); float wr_[32];
#pragma unroll
                for (int jj = 0; jj < 32; ++jj) wr_[jj] = w2[jj * 384 + c];
                const float w0 = p.b_w0[l * 384 + c];
#pragma unroll 1
                for (int tok = 0; tok < 16; ++tok) {
                    const float* ap = ps + tok * 1280 + 1152; float acc = w0;
#pragma unroll
                    for (int jj = 0; jj < 32; jj += 4) { const f32x4 t = *(const f32x4*)(ap + jj); acc += t.x * wr_[jj] + t.y * wr_[jj + 1] + t.z * wr_[jj + 2] + t.w * wr_[jj + 3]; }
                    const float wl = -softplusf_(-acc) - 0.5f;
                    const float omw = -expm1f(-__expf(wl));
                    PS[((size_t)(row0 + tok) * 6 + h) * 320 + 0 * 64 + j] = f2bf(omw);
                }
            }
            if (l == 0) {
#pragma unroll 1
                for (int tok = 0; tok < 16; ++tok) {
                    const bf16_t vb = f2bf(ps[tok * 1280 + 768 + c]);
                    VF[(size_t)(row0 + tok) * 384 + c] = vb; PV[(size_t)(row0 + tok) * 384 + c] = vb;
                }
            } else {
                OPQ_C(); float wr_[16];
#pragma unroll
                for (int jj = 0; jj < 16; ++jj) wr_[jj] = v2[jj * 384 + c];
                const float v0 = p.b_v0[(l - 1) * 384 + c];
#pragma unroll 1
                for (int tok = 0; tok < 16; ++tok) {
                    const float* ap = vlo + tok * 16; float acc = v0;
#pragma unroll
                    for (int jj = 0; jj < 16; jj += 4) { const f32x4 t = *(const f32x4*)(ap + jj); acc += t.x * wr_[jj] + t.y * wr_[jj + 1] + t.z * wr_[jj + 2] + t.w * wr_[jj + 3]; }
                    const float vp = ps[tok * 1280 + 768 + c], vf = bf2f(VF[(size_t)(row0 + tok) * 384 + c]);
                    PV[(size_t)(row0 + tok) * 384 + c] = f2bf(vp + (vf - vp) * sigmoidf_(acc));
                }
            }
            {
                OPQ_C();
                const float kk_ = p.b_k_k[l * 384 + c], ka_ = p.b_k_a[l * 384 + c], rk_ = p.b_r_k[l * 384 + c];
#pragma unroll 1
                for (int tok = 0; tok < 16; ++tok) {
                    const float kp = ps[tok * 1280 + 384 + c], rp = ps[tok * 1280 + c], a = as_[tok * 384 + c];
                    const float kkr = kp * kk_;
                    const float ss = sum64(kkr * kkr);
                    const float kk = kkr / fmaxf(sqrtf(ss), 1e-12f);
                    const float kmod = kp * (1.f + (a - 1.f) * ka_);
                    const float bon = sum64(rp * kmod * rk_);
                    bf16_t* o = PS + ((size_t)(row0 + tok) * 6 + h) * 320 + j;
                    o[64] = f2bf(kk); o[128] = f2bf(kk * a); o[192] = f2bf(kmod); o[256] = f2bf(rp);
                    if (j == 0) BONUS[(size_t)(row0 + tok) * 8 + h] = bon;
                }
            }
            {
                OPQ_C(); float wr_[32];
#pragma unroll
                for (int jj = 0; jj < 32; ++jj) wr_[jj] = g2[jj * 384 + c];
#pragma unroll 1
                for (int tok = 0; tok < 16; ++tok) {
                    const float* ap = ps + tok * 1280 + 1216; float acc = 0.f;
#pragma unroll
                    for (int jj = 0; jj < 32; jj += 4) { const f32x4 t = *(const f32x4*)(ap + jj); acc += t.x * wr_[jj] + t.y * wr_[jj + 1] + t.z * wr_[jj + 2] + t.w * wr_[jj + 3]; }
                    as2[tok * 384 + c] = acc;
                }
                OPQ_C();
#pragma unroll
                for (int jj = 0; jj < 32; ++jj) wr_[jj] = g2[(32 + jj) * 384 + c];
#pragma unroll 1
                for (int tok = 0; tok < 16; ++tok) {
                    const float* ap = ps + tok * 1280 + 1248; float acc = as2[tok * 384 + c];
#pragma unroll
                    for (int jj = 0; jj < 32; jj += 4) { const f32x4 t = *(const f32x4*)(ap + jj); acc += t.x * wr_[jj] + t.y * wr_[jj + 1] + t.z * wr_[jj + 2] + t.w * wr_[jj + 3]; }
                    PG[(size_t)(row0 + tok) * 384 + c] = f2bf(acc);
                }
            }
        }
        __syncthreads();
    }
#undef OPQ_C
}
constexpr int SB_TOK = 320, SB_BUF = 16 * SB_TOK;
constexpr int SC_TOK = 192, SC_BUF = 16 * SC_TOK;
__device__ __forceinline__ void scan_bc(const Params& p, float* lds, int slot, int l) {
    const int tid = opaque_tid(), half = tid >> 8, t2 = tid & 255, r = t2 >> 4, ks = t2 & 15;
    float* sb = lds;
    float* sv = sb + 2 * SB_BUF;
    float* sy = sv + 2 * 256;
    float* sc = sy + 2 * 256;
    float* si = sc + 2 * SC_BUF;
    float* so = si + 2 * 256;
    float* slb = so + 2 * 256;
    const bf16_t* proj = (const bf16_t*)(p.ws + WS_PROJ);
    float* projf = (float*)(p.ws + WS_PROJ);
    const bf16_t* PS = (const bf16_t*)(p.ws + WS_PS); const bf16_t* PV = (const bf16_t*)(p.ws + WS_PV);
    float* YRAW = (float*)(p.ws + WS_HB);
    const int bb = (slot >> 2) / 6, bh = (slot >> 2) % 6, rg = slot & 3;
    const bool hasc = slot < 128;
    const int cb = (slot >> 2) >> 2, ch = (slot >> 2) & 3, vg = slot & 3;
    const bool active = half == 0 || hasc;
    const int ub = half == 0 ? bb : cb;
    if (half == 1 && hasc && t2 < 64) {
        const int c = ch * 64 + t2;
        float v[4], m = -1e30f;
#pragma unroll
        for (int i = 0; i < 4; ++i) { v[i] = p.c_lb[i * 256 + c]; m = fmaxf(m, v[i]); }
        float den = 0.f, num = 0.f;
#pragma unroll
        for (int i = 0; i < 4; ++i) { const float e = __expf(v[i] - m); den += e; if (i >= 1 && i <= l) num += e; }
        slb[t2] = num / den;
    }
    __syncthreads();
    u32x4 pre[3]; u32x4 prev_ = {0u, 0u, 0u, 0u};
    f32x4 S = {0.f, 0.f, 0.f, 0.f};
#define SCAN_ROW(tile, tok) ((tile) == 0 ? MROWS + (tok) : ub * SEQ + ((tile) - 1) * 16 + (tok))
    auto issue = [&](int tile) __attribute__((always_inline)) {
        if (half == 0) {
#pragma unroll
            for (int i = 0; i < 3; ++i) {
                const int q = t2 + i * 256;
                if (q < 640) { const int tok = q / 40, w = q % 40; pre[i] = *(const u32x4*)(PS + ((size_t)SCAN_ROW(tile, tok) * 6 + bh) * 320 + w * 8); }
            }
            if (t2 < 32) { const int tok = t2 >> 1, h8 = t2 & 1; prev_ = *(const u32x4*)(PV + (size_t)SCAN_ROW(tile, tok) * 384 + bh * 64 + rg * 16 + h8 * 8); }
        } else if (hasc) {
#pragma unroll
            for (int i = 0; i < 2; ++i) {
                const int q = t2 + i * 256;
                if (q < 288) {
                    const int tok = q / 18, w = q % 18;
                    const int col = w < 8 ? PC_Q + ch * 64 + w * 8 : (w < 16 ? PC_FZ + ch * 64 + (w - 8) * 8 : PC_I + ch * 64 + vg * 16 + (w - 16) * 8);
                    pre[i] = *(const u32x4*)(proj + (size_t)SCAN_ROW(tile, tok) * NIN + col);
                }
            }
        }
    };
    auto commit = [&](int buf) __attribute__((always_inline)) {
        if (half == 0) {
#pragma unroll
            for (int i = 0; i < 3; ++i) {
                const int q = t2 + i * 256;
                if (q < 640) {
                    const int tok = q / 40, w = q % 40; float f[8]; unpack8(pre[i], f);
                    float* d = sb + buf * SB_BUF + tok * SB_TOK + w * 8;
                    *(f32x4*)d = (f32x4){f[0], f[1], f[2], f[3]}; *(f32x4*)(d + 4) = (f32x4){f[4], f[5], f[6], f[7]};
                }
            }
            if (t2 < 32) {
                const int tok = t2 >> 1, h8 = t2 & 1; float f[8]; unpack8(prev_, f);
                float* d = sv + buf * 256 + tok * 16 + h8 * 8;
                *(f32x4*)d = (f32x4){f[0], f[1], f[2], f[3]}; *(f32x4*)(d + 4) = (f32x4){f[4], f[5], f[6], f[7]};
            }
        } else if (hasc) {
#pragma unroll
            for (int i = 0; i < 2; ++i) {
                const int q = t2 + i * 256;
                if (q < 288) {
                    const int tok = q / 18, w = q % 18; float f[8]; unpack8(pre[i], f);
                    if (w < 8) {
#pragma unroll
                        for (int e = 0; e < 8; ++e) f[e] = siluf_(f[e]);
                        float* d = sc + buf * SC_BUF + tok * SC_TOK + w * 8;
                        *(f32x4*)d = (f32x4){f[0], f[1], f[2], f[3]}; *(f32x4*)(d + 4) = (f32x4){f[4], f[5], f[6], f[7]};
                    } else if (w < 16) {
                        float g[8];
#pragma unroll
                        for (int e = 0; e < 8; ++e) { const float lb = slb[(w - 8) * 8 + e]; f[e] = lb + (1.f - lb) * sigmoidf_(f[e]); g[e] = 1.f - f[e]; }
                        float* d = sc + buf * SC_BUF + tok * SC_TOK + 64 + (w - 8) * 8;
                        *(f32x4*)d = (f32x4){f[0], f[1], f[2], f[3]}; *(f32x4*)(d + 4) = (f32x4){f[4], f[5], f[6], f[7]};
                        *(f32x4*)(d + 64) = (f32x4){g[0], g[1], g[2], g[3]}; *(f32x4*)(d + 68) = (f32x4){g[4], g[5], g[6], g[7]};
                    } else {
                        float* d = si + buf * 256 + tok * 16 + (w - 16) * 8;
                        *(f32x4*)d = (f32x4){f[0], f[1], f[2], f[3]}; *(f32x4*)(d + 4) = (f32x4){f[4], f[5], f[6], f[7]};
                    }
                }
            }
        }
    };
    issue(0); commit(0);
    __syncthreads();
    for (int tile = 0; tile < 129; ++tile) {
        const int buf = tile & 1;
        if (tile + 1 < 129) issue(tile + 1);
        if (half == 0) {
            const float* T = sb + buf * SB_BUF + ks * 4;
            const float* V = sv + buf * 256 + r;
            float* Y = sy + buf * 256 + r;
#pragma unroll
            for (int tok = 0; tok < 16; ++tok) {
                const f32x4 omw = *(const f32x4*)(T + tok * SB_TOK), kk = *(const f32x4*)(T + tok * SB_TOK + 64), kka = *(const f32x4*)(T + tok * SB_TOK + 128);
                const f32x4 kx = *(const f32x4*)(T + tok * SB_TOK + 192), rr = *(const f32x4*)(T + tok * SB_TOK + 256);
                const float vv = V[tok * 16];
                float d = (S.x * kk.x + S.y * kk.y) + (S.z * kk.z + S.w * kk.w);
                d = sum16(d);
                const float sa = -d;
                S = S - S * omw;
                S = S + sa * kka;
                S = S + vv * kx;
                float y = (S.x * rr.x + S.y * rr.y) + (S.z * rr.z + S.w * rr.w);
                y = sum16(y);
                if (ks == 0) Y[tok * 16] = y;
            }
        } else if (hasc) {
            const float* T = sc + buf * SC_BUF + ks * 4;
            const float* V = si + buf * 256 + r;
            float* Y = so + buf * 256 + r;
#pragma unroll
            for (int tok = 0; tok < 16; ++tok) {
                const f32x4 qq = *(const f32x4*)(T + tok * SC_TOK), ff = *(const f32x4*)(T + tok * SC_TOK + 64), kin = *(const f32x4*)(T + tok * SC_TOK + 128);
                const float iv = V[tok * 16];
                S = ff * S + kin * iv;
                float o = (S.x * qq.x + S.y * qq.y) + (S.z * qq.z + S.w * qq.w);
                o = sum16(o);
                if (ks == 0) Y[tok * 16] = o;
            }
        }
        if (tile + 1 < 129) commit(buf ^ 1);
        __syncthreads();
        if (active && t2 < 64 && (tile > 0 || ub == 0)) {
            const int tok = t2 >> 2, q4 = (t2 & 3) * 4, row = SCAN_ROW(tile, tok);
            if (half == 0) *(f32x4*)(YRAW + (size_t)row * 384 + bh * 64 + rg * 16 + q4) = *(const f32x4*)(sy + buf * 256 + tok * 16 + q4);
            else *(f32x4*)(projf + (size_t)row * 1536 + ORAW_F + ch * 64 + vg * 16 + q4) = *(const f32x4*)(so + buf * 256 + tok * 16 + q4);
        }
    }
#undef SCAN_ROW
    __syncthreads();
}
__device__ __forceinline__ void scan_a(const Params& p, unsigned char* ldsb, int ua, int l) {
    const int tid = opaque_tid(), wid = tid >> 6, lane = tid & 63;
    const int b = ua / 6, ha = ua % 6, c0 = ha * 64;
    float* xs = (float*)ldsb;
    float* gs = xs + 67 * 64;
    float* us = gs + 64 * 64;
    float* gt = us + 64 * 64;
    float* seg = gt + 64 * 132;
    float* hc = seg + 8 * 64 * 2;
    bf16_t* ub = (bf16_t*)(hc + 128);
    bf16_t* wt = ub + 64 * 72;
    bf16_t* proj = (bf16_t*)(p.ws + WS_PROJ); bf16_t* ymeta = (bf16_t*)(p.ws + WS_YMETA);
    const int c = tid & 63, tg = tid >> 6;
    const float cw0 = p.a_conv_w[(l * 4 + 0) * 384 + c0 + c], cw1 = p.a_conv_w[(l * 4 + 1) * 384 + c0 + c], cw2 = p.a_conv_w[(l * 4 + 2) * 384 + c0 + c], cw3 = p.a_conv_w[(l * 4 + 3) * 384 + c0 + c];
    const float cbias = p.a_conv_b[l * 384 + c0 + c], br = p.a_b_r[l * 384 + c0 + c], bi = p.a_b_i[l * 384 + c0 + c];
    const float spl8 = 8.f * softplusf_(-p.a_lambda[l * 384 + c0 + c]);
    {
        const float* wr_ = p.a_w_r + ((size_t)(l * 6 + ha)) * 4096; const float* wi_ = p.a_w_i + ((size_t)(l * 6 + ha)) * 4096;
        for (int q = tid; q < 8192; q += NTHREADS) {
            const int g = q >> 12, k = (q >> 6) & 63, n = q & 63;
            wt[(g * 64 + n) * 72 + k] = f2bf(g ? wi_[k * 64 + n] : wr_[k * 64 + n]);
        }
        if (tid < 192) xs[tid] = 0.f;
        if (tid < 128) hc[tid] = 0.f;
    }
    __syncthreads();
    bf16x8 bfr[2];
    {
        const int n = lane & 15, quad = lane >> 4;
        bfr[0] = *(const bf16x8*)(wt + (wid * 16 + n) * 72 + quad * 8);
        bfr[1] = *(const bf16x8*)(wt + (wid * 16 + n) * 72 + 32 + quad * 8);
    }
    u32x4 px = {0u, 0u, 0u, 0u}, pg = {0u, 0u, 0u, 0u};
    const int ltok = tid >> 3, lc8 = (tid & 7) * 8;
#define A_ROW(tile, tok) ((tile) == 0 ? MROWS + (tok) : b * SEQ + ((tile) - 1) * 64 + (tok))
#define A_NTOK(tile) ((tile) == 0 ? 16 : 64)
    if (ltok < A_NTOK(0)) { const size_t ro = (size_t)A_ROW(0, ltok) * NIN; px = *(const u32x4*)(proj + ro + PC_XA + c0 + lc8); pg = *(const u32x4*)(proj + ro + PC_GA + c0 + lc8); }
    for (int tile = 0; tile < 33; ++tile) {
        const int ntok = A_NTOK(tile), cur = tile & 1;
        {
            float f[8]; unpack8(px, f);
            *(f32x4*)(xs + (3 + ltok) * 64 + lc8) = (f32x4){f[0], f[1], f[2], f[3]}; *(f32x4*)(xs + (3 + ltok) * 64 + lc8 + 4) = (f32x4){f[4], f[5], f[6], f[7]};
            unpack8(pg, f);
            *(f32x4*)(gs + ltok * 64 + lc8) = (f32x4){f[0], f[1], f[2], f[3]}; *(f32x4*)(gs + ltok * 64 + lc8 + 4) = (f32x4){f[4], f[5], f[6], f[7]};
        }
        __syncthreads();
        if (tile + 1 < 33 && ltok < A_NTOK(tile + 1)) { const size_t ro = (size_t)A_ROW(tile + 1, ltok) * NIN; px = *(const u32x4*)(proj + ro + PC_XA + c0 + lc8); pg = *(const u32x4*)(proj + ro + PC_GA + c0 + lc8); }
#pragma unroll
        for (int i = 0; i < 8; ++i) {
            const int tok = tg * 8 + i;
            const float u = cbias + cw0 * xs[tok * 64 + c] + cw1 * xs[(tok + 1) * 64 + c] + cw2 * xs[(tok + 2) * 64 + c] + cw3 * xs[(tok + 3) * 64 + c];
            us[tok * 64 + c] = u; ub[tok * 72 + c] = f2bf(u);
        }
        __syncthreads();
        {
            const int m = lane & 15, quad = lane >> 4;
#pragma unroll
            for (int mb = 0; mb < 4; ++mb) {
                const bf16x8 a0 = *(const bf16x8*)(ub + (mb * 16 + m) * 72 + quad * 8), a1 = *(const bf16x8*)(ub + (mb * 16 + m) * 72 + 32 + quad * 8);
                f32x4 acc = {0.f, 0.f, 0.f, 0.f};
                acc = __builtin_amdgcn_mfma_f32_16x16x32_bf16(a0, bfr[0], acc, 0, 0, 0);
                acc = __builtin_amdgcn_mfma_f32_16x16x32_bf16(a1, bfr[1], acc, 0, 0, 0);
#pragma unroll
                for (int j = 0; j < 4; ++j) gt[(mb * 16 + quad * 4 + j) * 132 + wid * 16 + m] = acc[j];
            }
        }
        __syncthreads();
        {
            float Ap = 1.f, hl = 0.f;
#pragma unroll
            for (int i = 0; i < 8; ++i) {
                const int tok = tg * 8 + i;
                float a = 1.f, dr = 0.f;
                if (tok < ntok) {
                    const float rr = sigmoidf_(gt[tok * 132 + c] + br), ii = sigmoidf_(gt[tok * 132 + 64 + c] + bi);
                    const float la = -rr * spl8;
                    a = __expf(la);
                    dr = sqrtf(fmaxf(-expm1f(2.f * la), 0.f)) * (ii * us[tok * 64 + c]);
                }
                hl = a * hl + dr; Ap *= a;
                gt[tok * 132 + c] = hl; gt[tok * 132 + 64 + c] = Ap;
            }
            seg[(tg * 64 + c) * 2] = Ap; seg[(tg * 64 + c) * 2 + 1] = hl;
        }
        float hist = 0.f;
        if (tid < 192) hist = xs[(ntok + (tid >> 6)) * 64 + c];
        __syncthreads();
        if (tid < 192) xs[(tid >> 6) * 64 + c] = hist;
        {
            float carry = hc[cur * 64 + c];
            for (int s = 0; s < tg; ++s) carry = seg[(s * 64 + c) * 2] * carry + seg[(s * 64 + c) * 2 + 1];
            float hlast = carry;
#pragma unroll
            for (int i = 0; i < 8; ++i) {
                const int tok = tg * 8 + i;
                const float h = gt[tok * 132 + c] + gt[tok * 132 + 64 + c] * carry;
                hlast = h;
                if (tok < ntok) {
                    const float y = h * geluf_(gs[tok * 64 + c]);
                    if (tile > 0) proj[(size_t)A_ROW(tile, tok) * NIN + PC_YA + c0 + c] = f2bf(y);
                    else if (b == 0) ymeta[tok * 1024 + c0 + c] = f2bf(y);
                }
            }
            if (tg == 7) hc[(cur ^ 1) * 64 + c] = hlast;
        }
        __syncthreads();
    }
#undef A_ROW
#undef A_NTOK
}
__device__ __forceinline__ void phase_post(const Params& p, int l) {
    const int tid = opaque_tid(), wid = tid >> 6, lane = tid & 63;
    const int gw = opaque_bid() * 8 + wid, nw = gridDim.x * 8;
    bf16_t* proj = (bf16_t*)(p.ws + WS_PROJ); const float* projf = (const float*)(p.ws + WS_PROJ);
    const float* YRAW = (const float*)(p.ws + WS_HB);
    const bf16_t* PV = (const bf16_t*)(p.ws + WS_PV); const bf16_t* PG = (const bf16_t*)(p.ws + WS_PG);
    const float* BONUS = (const float*)(p.ws + WS_BONUS);
    bf16_t* ymeta = (bf16_t*)(p.ws + WS_YMETA);
    for (int task = gw; task < RROWS * 10; task += nw) {
        const int row = task / 10, hh = task % 10;
        if (hh < 6) {
            const int cc = hh * 64 + lane;
            const float y = YRAW[(size_t)row * 384 + cc];
            const float mean = sum64(y) * (1.f / 64.f);
            const float dlt = y - mean;
            const float var = sum64(dlt * dlt) * (1.f / 64.f);
            float o = dlt * rsqrtf(var + 64e-5f) * p.b_ln_g[l * 384 + cc] + p.b_ln_b[l * 384 + cc];
            o += BONUS[(size_t)row * 8 + hh] * bf2f(PV[(size_t)row * 384 + cc]);
            o *= bf2f(PG[(size_t)row * 384 + cc]);
            if (row < MROWS) proj[(size_t)row * NIN + PC_YB + cc] = f2bf(o);
            else ymeta[(row - MROWS) * 1024 + 384 + cc] = f2bf(o);
        } else {
            const int hc = hh - 6, cc = hc * 64 + lane;
            const float o = projf[(size_t)row * 1536 + ORAW_F + cc];
            const float ms = sum64(o * o) * (1.f / 64.f);
            const float og = bf2f(proj[(size_t)row * NIN + PC_OG + cc]);
            const float r = o * rsqrtf(ms + 1e-6f) * p.c_norm[l * 64 + lane] * siluf_(og);
            if (row < MROWS) proj[(size_t)row * NIN + PC_YC + cc] = f2bf(r);
            else ymeta[(row - MROWS) * 1024 + 768 + cc] = f2bf(r);
        }
    }
}

#ifndef PHMASK
#define PHMASK 0x1ff
#endif
#define PHM(k) (((PHMASK) >> (k)) & 1)
__global__ void __launch_bounds__(NTHREADS, 2) hymba_fwd(Params pin) {
#if defined(__HIP_DEVICE_COMPILE__)
    extern __shared__ __attribute__((aligned(16))) unsigned char shm[];
    cg::grid_group grid = cg::this_grid();
    float* ldsf = (float*)shm;
    pg8::StaticOrder S;
    typedef const __attribute__((address_space(4))) Params* KP;
    for (int ph = pin.ph_lo; ph < pin.ph_hi; ++ph) {
        KP kp = (KP)__builtin_amdgcn_kernarg_segment_ptr(); asm volatile("" : "+s"(kp));
        const Params p = *kp;
        unsigned char* ws = p.ws;
        bf16_t* W0 = (bf16_t*)(ws + WS_W0); bf16_t* W1 = (bf16_t*)(ws + WS_W0 + WS_WSLOT);
        bf16_t* HB = (bf16_t*)(ws + WS_HB); bf16_t* PROJ = (bf16_t*)(ws + WS_PROJ); bf16_t* U = PROJ;
        unsigned long long* SSQ = (unsigned long long*)(ws + WS_SSQ); float* HMETA = (float*)(ws + WS_HMETA); bf16_t* YMETA = (bf16_t*)(ws + WS_YMETA);
        if (PHM(0) && ph == 0) {
            phase_p0(p);
            conv_w(ldsf, p.w_in, 1024, NIN, W0, p.mix_norm);
        } else if (PHM(8) && ph == 29) {
            phase_final(p);
        } else {
            const int l = (ph - 1) / 7, sub = (ph - 1) % 7;
            if (PHM(1) && sub == 0) {
                EpScale<0> E{PROJ, NIN, SSQ + (size_t)(2 * l) * RROWS};
                meta_gemm(ldsf, HB + (size_t)MROWS * 1024, 1024, W0, NIN, 1024, E);
                pg8::Gemm g{HB, W0, MROWS, NIN, 1024, 1024};
                S.init(MROWS, NIN, (int)gridDim.x, (int)opaque_bid());
                pg8::gemm_phase<EpScale<0>, pg8::StaticOrder, false>((PG8_LAS unsigned char*)shm, g, S, E);
            } else if (PHM(2) && sub == 1) {
                conv_w(ldsf, p.w_out + (size_t)l * 1024 * 1024, 1024, 1024, W1, nullptr);
                conv_w(ldsf, p.w_up + (size_t)l * 1024 * DFF, 1024, DFF, W0, p.ffn_norm + l * 1024);
                __syncthreads();
                phase_prep(p, ldsf, l);
            } else if (PHM(3) && sub == 2) {
                for (int s = opaque_bid(); s < 240; s += gridDim.x) {
                    if (s < 192) scan_bc(p, ldsf, s, l); else scan_a(p, shm, s - 192, l);
                    __syncthreads();
                }
            } else if (PHM(4) && sub == 3) {
                phase_post(p, l);
            } else if (PHM(5) && sub == 4) {
                EpRes E{l == 0 ? p.x : p.out, p.out, HMETA, HB, SSQ + (size_t)(2 * l + 1) * RROWS};
                meta_gemm(ldsf, YMETA, 1024, W1, 1024, 1024, E);
                pg8::Gemm g{PROJ, W1, MROWS, 1024, 1024, NIN};
                S.init(MROWS, 1024, (int)gridDim.x, (int)opaque_bid());
                pg8::gemm_phase<EpRes, pg8::StaticOrder, false>((PG8_LAS unsigned char*)shm, g, S, E);
            } else if (PHM(6) && sub == 5) {
                conv_w(ldsf, p.w_down + (size_t)l * DFF * 1024, DFF, 1024, W1, nullptr);
                __syncthreads();
                EpScale<1> E{U, DFF, SSQ + (size_t)(2 * l + 1) * RROWS};
                meta_gemm(ldsf, HB + (size_t)MROWS * 1024, 1024, W0, DFF, 1024, E);
                pg8::Gemm g{HB, W0, MROWS, DFF, 1024, 1024};
                S.init(MROWS, DFF, (int)gridDim.x, (int)opaque_bid());
                pg8::gemm_phase<EpScale<1>, pg8::StaticOrder, false>((PG8_LAS unsigned char*)shm, g, S, E);
            } else if (PHM(7)) {
                if (l + 1 < DEPTH) { conv_w(ldsf, p.w_in + (size_t)(l + 1) * 1024 * NIN, 1024, NIN, W0, p.mix_norm + (l + 1) * 1024); __syncthreads(); }
                EpRes E{p.out, p.out, HMETA, HB, SSQ + (size_t)(2 * l + 2) * RROWS};
                meta_gemm(ldsf, U + (size_t)MROWS * DFF, DFF, W1, 1024, DFF, E);
                pg8::Gemm g{U, W1, MROWS, 1024, DFF, DFF};
                S.init(MROWS, 1024, (int)gridDim.x, (int)opaque_bid());
                pg8::gemm_phase<EpRes, pg8::StaticOrder, false>((PG8_LAS unsigned char*)shm, g, S, E);
            }
        }
        if (ph + 1 < pin.ph_hi) grid.sync();
    }
#endif
}

extern "C" void kernel_launch(void* const* d_in, const int* in_sizes, int n_in, void* d_out, int out_size, void* d_ws, size_t ws_size, hipStream_t stream) {
    static int grid_blocks = 0;
    if (grid_blocks == 0) {
        if (n_in != 32 || ws_size < WS_END) { fprintf(stderr, "kernel_launch: unexpected n_in %d / ws_size %zu (need %zu)\n", n_in, ws_size, (size_t)WS_END); grid_blocks = -1; return; }
        int dev = 0, cus = 0, per_cu = 0;
        hipGetDevice(&dev);
        hipDeviceGetAttribute(&cus, hipDeviceAttributeMultiprocessorCount, dev);
        if (hipFuncSetAttribute((const void*)hymba_fwd, hipFuncAttributeMaxDynamicSharedMemorySize, LDS_BYTES) != hipSuccess) { fprintf(stderr, "hipFuncSetAttribute failed\n"); grid_blocks = -1; return; }
        if (hipOccupancyMaxActiveBlocksPerMultiprocessor(&per_cu, (const void*)hymba_fwd, NTHREADS, LDS_BYTES) != hipSuccess || per_cu < 1) { fprintf(stderr, "occupancy query failed (%d)\n", per_cu); (void)hipGetLastError(); per_cu = 1; }
        grid_blocks = cus * (per_cu > 1 ? 1 : per_cu);
        fprintf(stderr, "kernel_launch: %d CUs, %d blocks/CU by query, grid %d\n", cus, per_cu, grid_blocks);
    }
    if (grid_blocks < 0) return;
    Params p{};
    const float** pp = (const float**)&p;
    for (int i = 0; i < 32; ++i) pp[i] = (const float*)d_in[i];
    p.out = (float*)d_out; p.ws = (unsigned char*)d_ws;
#ifndef MK_PER_PHASE
    p.ph_lo = 0; p.ph_hi = 30;
    void* args[] = {&p};
    hipError_t e = hipLaunchCooperativeKernel((const void*)hymba_fwd, dim3(grid_blocks), dim3(NTHREADS), args, LDS_BYTES, stream);
    if (e != hipSuccess) fprintf(stderr, "cooperative launch failed: %s (grid %d)\n", hipGetErrorString(e), grid_blocks);
#else
    for (int ph = 0; ph < 30; ++ph) {
        p.ph_lo = ph; p.ph_hi = ph + 1;
        hipLaunchKernelGGL(hymba_fwd, dim3(grid_blocks), dim3(NTHREADS), LDS_BYTES, stream, p);
    }
#endif
}
```

```cpp
#include <hip/hip_runtime.h>
#include <hip/hip_cooperative_groups.h>
#include <cstdio>
namespace cg = cooperative_groups;

#define LAS __attribute__((address_space(3)))
typedef unsigned short bf16_t;
typedef short bf16x8 __attribute__((ext_vector_type(8)));
typedef float f32x4 __attribute__((ext_vector_type(4)));
typedef float f32x2 __attribute__((ext_vector_type(2)));
typedef unsigned u32x4 __attribute__((ext_vector_type(4)));
typedef unsigned u32x2 __attribute__((ext_vector_type(2)));

constexpr int D = 1024, NBATCH = 8, SEQ = 2048, NMETA = 16, LTOK = SEQ + NMETA, MROWS = NBATCH * SEQ, RROWS = MROWS + NMETA, DEPTH = 4;
constexpr int NIN = 3072, DFF = 4096, BCOLS = 1280;
constexpr int LDS_BYTES = 131072, LDS_ALLOC = LDS_BYTES + 16, NTHREADS = 512;
constexpr int PC_XA = 0, PC_GA = 384, PC_B = 768, PC_Q = 2048, PC_FZ = 2304, PC_I = 2560, PC_OG = 2816;
constexpr int PC_YA = 0, PC_YB = 384, PC_YC = 768;
constexpr size_t ACB_F = 8388608;
constexpr size_t WTL_F = 9437184;
constexpr int ORAW_F = 576;

constexpr size_t WS_WIN = 0, WS_WOUT = 6291456, WS_WUP = 8388608, WS_WDN = 16777216;
constexpr size_t WS_HB = 25165824;
constexpr size_t WS_PROJ = WS_HB + (size_t)RROWS * 1024 * 2;
constexpr size_t WS_PS = WS_PROJ + (size_t)RROWS * 3072 * 2;
constexpr size_t WS_PV = WS_PS + (size_t)RROWS * 6 * 320 * 2;
constexpr size_t WS_PG = WS_PV + (size_t)RROWS * 384 * 2;
constexpr size_t WS_VF = WS_PG + (size_t)RROWS * 384 * 2;
constexpr size_t WS_BONUS = WS_VF + (size_t)RROWS * 384 * 2;
constexpr size_t WS_SSQ = WS_BONUS + (size_t)RROWS * 8 * 4;
constexpr size_t WS_HMETA = WS_SSQ + (size_t)9 * RROWS * 8;
constexpr size_t WS_YMETA = WS_HMETA + (size_t)16 * 1024 * 4;
constexpr size_t WS_BAR = WS_YMETA + (size_t)16 * 1024 * 2;
constexpr size_t WS_END = WS_BAR + 16384;
static_assert((size_t)RROWS * 4096 * 2 <= WS_VF - WS_PROJ, "U must fit in PROJ..PG");
static_assert((size_t)RROWS * 384 * 4 <= (size_t)RROWS * 1024 * 2, "YRAW must fit in HB");
static_assert(WS_END <= 268435456ull, "workspace");

struct Params {
    const float *x, *meta, *mix_norm, *w_in, *a_conv_w, *a_conv_b, *a_w_r, *a_b_r, *a_w_i, *a_b_i, *a_lambda;
    const float *b_mu, *b_w0, *b_w2, *b_a0, *b_a2, *b_g2, *b_k_k, *b_k_a, *b_r_k, *b_ln_g, *b_ln_b, *b_v0, *b_v1, *b_v2;
    const float *c_lb, *c_norm, *w_out, *ffn_norm, *w_up, *w_down, *final_norm;
    float* out; unsigned char* ws;
    int ph_lo, ph_hi;
};

__device__ __forceinline__ int opaque_bid() { int t = blockIdx.x; asm volatile("" : "+s"(t)); return t; }
__device__ __forceinline__ int opaque_tid() { int t = threadIdx.x; asm volatile("" : "+v"(t)); return t; }
__device__ __forceinline__ unsigned cvt_pk_bf16(float lo, float hi) { unsigned r; asm volatile("v_cvt_pk_bf16_f32 %0, %1, %2" : "=v"(r) : "v"(lo), "v"(hi)); return r; }
__device__ __forceinline__ bf16_t f2bf(float f) { return (bf16_t)(cvt_pk_bf16(f, 0.f) & 0xffffu); }
__device__ __forceinline__ float bf2f(unsigned short b) { return __uint_as_float(((unsigned)b) << 16); }
__device__ __forceinline__ float bflo(unsigned u) { return __uint_as_float(u << 16); }
__device__ __forceinline__ float bfhi(unsigned u) { return __uint_as_float(u & 0xffff0000u); }
__device__ __forceinline__ float rcpf_(float x) { return __builtin_amdgcn_rcpf(x); }
__device__ __forceinline__ float sigmoidf_(float x) { return rcpf_(1.f + __expf(-x)); }
__device__ __forceinline__ float siluf_(float x) { return x * sigmoidf_(x); }
__device__ __forceinline__ float softplusf_(float x) { return fmaxf(x, 0.f) + log1pf(__expf(-fabsf(x))); }
__device__ __forceinline__ float tanhf_(float x) { const float e = __expf(-2.f * fabsf(x)); const float t = (1.f - e) * rcpf_(1.f + e); return x < 0.f ? -t : t; }
__device__ __forceinline__ float geluf_(float x) { return 0.5f * x * (1.f + tanhf_(0.7978845608028654f * (x + 0.044715f * x * x * x))); }

template <int CTRL> __device__ __forceinline__ float dppf(float x) { return __builtin_bit_cast(float, __builtin_amdgcn_update_dpp(0, __builtin_bit_cast(int, x), CTRL, 0xF, 0xF, true)); }
template <int CTRL> __device__ __forceinline__ float dppf1(float x) { return __builtin_bit_cast(float, __builtin_amdgcn_update_dpp(0x3f800000, __builtin_bit_cast(int, x), CTRL, 0xF, 0xF, false)); }
__device__ __forceinline__ float sum16(float x) {
    x += dppf<0xB1>(x); x += dppf<0x4E>(x); x += dppf<0x141>(x); x += dppf<0x140>(x); return x;
}
__device__ __forceinline__ float sum64(float x) {
    x = sum16(x);
    const int xi = __builtin_bit_cast(int, x);
    const float a = __builtin_bit_cast(float, __builtin_amdgcn_readlane(xi, 0)), b = __builtin_bit_cast(float, __builtin_amdgcn_readlane(xi, 16));
    const float c = __builtin_bit_cast(float, __builtin_amdgcn_readlane(xi, 32)), d = __builtin_bit_cast(float, __builtin_amdgcn_readlane(xi, 48));
    return (a + b) + (c + d);
}
__device__ __forceinline__ void unpack8(const u32x4 v, float* f) {
    f[0] = bflo(v.x); f[1] = bfhi(v.x); f[2] = bflo(v.y); f[3] = bfhi(v.y); f[4] = bflo(v.z); f[5] = bfhi(v.z); f[6] = bflo(v.w); f[7] = bfhi(v.w);
}
namespace pg8 {
#define PG8_LAS __attribute__((address_space(3)))
constexpr int BM = 256, BK = 64, HALF = 128, HTB = HALF * BK * 2  , STAGE_BYTES = 8 * HTB, NXCD = 8, WGM = 8;

__host__ __device__ __forceinline__ int lds_byte(int r, int c) { const int st = (r >> 4) * 2 + (c >> 5), rr = r & 15, cc = c & 31, ob = rr * 64 + cc * 2; return st * 1024 + (ob ^ (((ob >> 9) & 1) << 5)); }
__host__ __device__ __forceinline__ void stage_rc(int b, int& R, int& C) { const int st = b / 1024, sb = b % 1024, swz = sb ^ (((sb >> 9) & 1) << 5); R = (st >> 1) * 16 + swz / 64; C = (st & 1) * 32 + (swz % 64) / 2; }
__host__ __device__ __forceinline__ int perm32(int rho) { const int n = rho >> 4, i = rho & 15; return 8 * (i >> 2) + 4 * n + (i & 3); }

struct Unit { int pm, pn; };
struct Gemm { const bf16_t* A; const bf16_t* Bt; int M, N, K, lda; };

struct StaticOrder {
    int nM, nN, nwg, G, c;
    __host__ __device__ void init(int M, int N, int G_, int c_) { nM = M / BM; nN = N / BM; nwg = nM * nN; G = G_; c = c_; }
    __host__ __device__ bool next(int i, Unit& u) const {
        const long L = (long)i * G + c; if (L >= nwg) return false;
        int wgid = (int)L; { const int q = nwg / NXCD, r = nwg % NXCD, xcd = wgid % NXCD, off = wgid / NXCD; wgid = (xcd < r ? xcd * (q + 1) : r * (q + 1) + (xcd - r) * q) + off; }
        const int nig = WGM * nN, gid = wgid / nig, fm = gid * WGM, gsz = (nM - fm) < WGM ? (nM - fm) : WGM;
        u.pm = fm + ((wgid % nig) % gsz); u.pn = (wgid % nig) / gsz; return true;
    }
    __device__ __forceinline__ void a_ready(const Unit&) const {}
    __device__ __forceinline__ void done(const Unit&) const {}
};


template <class Epi, class Sched, bool AMAP>
__device__ __forceinline__ void gemm_phase(PG8_LAS unsigned char* lds, const Gemm g, const Sched& S, const Epi& E) {
    const int tid = opaque_tid(), wid = __builtin_amdgcn_readfirstlane(tid >> 6), lane = tid & 63, wr = wid >> 2, wc = wid & 3, fr = lane & 15, fq = lane >> 4;
    const int K = g.K, nt = K / BK;
    unsigned voffA[2], voffB[2];
#pragma unroll
    for (int i = 0; i < 2; ++i) { int R, C; stage_rc(tid * 16 + i * 8192, R, C); const int Rb = Epi::PERM ? ((R & ~31) + perm32(R & 31)) : R;
        voffA[i] = (unsigned)(R * g.lda + C) * 2u; voffB[i] = (unsigned)(Rb * K + C) * 2u; }
    const size_t kstep = (size_t)(BK * 2);
    const size_t hstep = (size_t)HALF * K * 2;
    const size_t tstep = 2 * hstep;
    const size_t hstepA = (size_t)HALF * g.lda * 2, tstepA = 2 * hstepA;
#define PG8_KOFS(t) ((size_t)(AMAP ? ((t) * 64 + ((t) >= 12 ? 1280 : ((t) >= 6 ? 384 : 0))) : (t) * 64) * 2)
    const unsigned ldsw = (unsigned)wid * 1024u;
    const int aoff = lds_byte(wr * 64 + fr, fq * 8), boff = lds_byte(wc * 32 + fr, fq * 8);
#define PG8_SA(b, h) (((b) * 2 + (h)) * HTB)
#define PG8_SB(b, h) ((4 + (b) * 2 + (h)) * HTB)
#define PG8_STAGE(bufoff, gbase, voff) do { _Pragma("unroll") for (int _i = 0; _i < 2; ++_i) \
        __builtin_amdgcn_global_load_lds((const unsigned*)((const char*)(gbase) + (voff)[_i]), (PG8_LAS unsigned*)(lds + (bufoff) + ldsw + _i * 8192), 16, 0, 0); } while (0)
#define PG8_LDA(dst, b, h) do { _Pragma("unroll") for (int m = 0; m < 4; ++m) _Pragma("unroll") for (int k = 0; k < 2; ++k) dst[m][k] = *(const PG8_LAS bf16x8*)(lds + PG8_SA(b, h) + aoff + m * 2048 + k * 1024); } while (0)
#define PG8_LDB(dst, b, h) do { _Pragma("unroll") for (int n = 0; n < 2; ++n) _Pragma("unroll") for (int k = 0; k < 2; ++k) dst[n][k] = *(const PG8_LAS bf16x8*)(lds + PG8_SB(b, h) + boff + n * 2048 + k * 1024); } while (0)
#define PG8_MMA(ai, bj, At, Bt) do { __builtin_amdgcn_s_setprio(1); _Pragma("unroll") for (int m = 0; m < 4; ++m) _Pragma("unroll") for (int n = 0; n < 2; ++n) _Pragma("unroll") for (int k = 0; k < 2; ++k) \
        acc[ai][bj][m][n] = __builtin_amdgcn_mfma_f32_16x16x32_bf16(Bt[n][k], At[m][k], acc[ai][bj][m][n], 0, 0, 0); __builtin_amdgcn_s_setprio(0); } while (0)
#define PG8_WAIT_V(n) asm volatile("s_waitcnt vmcnt(" #n ")" ::: "memory")
#define PG8_WAIT_L(n) asm volatile("s_waitcnt lgkmcnt(" #n ")" ::: "memory")
#define PG8_BAR __builtin_amdgcn_s_barrier()
#define PG8_SCHED __builtin_amdgcn_sched_barrier(0)
    Unit cur, nxt; int ui = 0;
    if (!S.next(0, cur)) return;
    f32x4 acc[2][2][4][2];
#pragma unroll
    for (int a = 0; a < 2; ++a)
#pragma unroll
        for (int b = 0; b < 2; ++b)
#pragma unroll
            for (int m = 0; m < 4; ++m)
#pragma unroll
                for (int n = 0; n < 2; ++n) acc[a][b][m][n] = (f32x4){0.f, 0.f, 0.f, 0.f};
    bf16x8 At[4][2], B0[2][2], B1[2][2];
    const char* cA = (const char*)g.A + (size_t)cur.pm * tstepA; const char* cB = (const char*)g.Bt + (size_t)cur.pn * tstep;
    S.a_ready(cur);
    PG8_STAGE(PG8_SB(0, 0), cB, voffB); PG8_STAGE(PG8_SA(0, 0), cA, voffA); PG8_STAGE(PG8_SB(0, 1), cB + hstep, voffB); PG8_STAGE(PG8_SA(0, 1), cA + hstepA, voffA);
    if (wr == 1) PG8_BAR;
    PG8_WAIT_V(4); PG8_BAR;
    PG8_STAGE(PG8_SB(1, 0), cB + kstep, voffB); PG8_STAGE(PG8_SA(1, 0), cA + PG8_KOFS(1), voffA); PG8_STAGE(PG8_SB(1, 1), cB + hstep + kstep, voffB);
    PG8_WAIT_V(6); PG8_BAR;
    for (;;) {
        const bool has_next = S.next(ui + 1, nxt);
        const char* nA = has_next ? (const char*)g.A + (size_t)nxt.pm * tstepA : cA; const char* nB = has_next ? (const char*)g.Bt + (size_t)nxt.pn * tstep : cB;
        for (int t = 0; t < nt; t += 2) {
            const bool last = (t == nt - 2);
            const char* a1 = cA + PG8_KOFS(t + 1);
            const char* a2 = last ? nA : cA + PG8_KOFS(t + 2); const char* b2 = last ? nB : cB + (size_t)(t + 2) * kstep;
            const char* a3 = last ? nA + PG8_KOFS(1) : cA + PG8_KOFS(t + 3); const char* b3 = b2 + kstep;
            if (last && has_next) S.a_ready(nxt);
            PG8_LDB(B0, 0, 0); PG8_SCHED; PG8_LDA(At, 0, 0); PG8_STAGE(PG8_SA(1, 1), a1 + hstepA, voffA);
            PG8_WAIT_L(8); PG8_BAR; PG8_WAIT_L(0); PG8_MMA(0, 0, At, B0); PG8_BAR; PG8_SCHED;
            PG8_LDB(B1, 0, 1); PG8_STAGE(PG8_SB(0, 0), b2, voffB);
            PG8_BAR; PG8_WAIT_L(0); PG8_MMA(0, 1, At, B1); PG8_BAR;
            PG8_LDA(At, 0, 1); PG8_STAGE(PG8_SA(0, 0), a2, voffA);
            PG8_BAR; PG8_WAIT_L(0); PG8_MMA(1, 0, At, B0); PG8_BAR; PG8_SCHED;
            PG8_STAGE(PG8_SB(0, 1), b2 + hstep, voffB);
            PG8_WAIT_V(6); PG8_BAR; PG8_MMA(1, 1, At, B1); PG8_BAR;
            PG8_LDB(B0, 1, 0); PG8_SCHED; PG8_LDA(At, 1, 0); PG8_STAGE(PG8_SA(0, 1), a2 + hstepA, voffA);
            PG8_WAIT_L(8); PG8_BAR; PG8_WAIT_L(0); PG8_MMA(0, 0, At, B0); PG8_BAR; PG8_SCHED;
            PG8_LDB(B1, 1, 1); PG8_STAGE(PG8_SB(1, 0), b3, voffB);
            PG8_BAR; PG8_WAIT_L(0); PG8_MMA(0, 1, At, B1); PG8_BAR;
            PG8_LDA(At, 1, 1); PG8_STAGE(PG8_SA(1, 0), a3, voffA);
            PG8_BAR; PG8_WAIT_L(0); PG8_MMA(1, 0, At, B0); PG8_BAR; PG8_SCHED;
            PG8_STAGE(PG8_SB(1, 1), b3 + hstep, voffB);
            PG8_WAIT_V(6); PG8_BAR; PG8_MMA(1, 1, At, B1); PG8_BAR;
        }
        if constexpr (!Epi::AFTER_DRAIN) { E(acc, cur, wr, wc, fr, fq); S.done(cur); }
        if (!has_next) break;
#pragma unroll
        for (int a = 0; a < 2; ++a)
#pragma unroll
            for (int b = 0; b < 2; ++b)
#pragma unroll
                for (int m = 0; m < 4; ++m)
#pragma unroll
                    for (int n = 0; n < 2; ++n) acc[a][b][m][n] = (f32x4){0.f, 0.f, 0.f, 0.f};
        cur = nxt; cA = nA; cB = nB; ++ui;
    }
    PG8_WAIT_V(0);
    if (wr == 0) PG8_BAR;
    PG8_BAR;
    if constexpr (Epi::AFTER_DRAIN) { E.fused(acc, cur, wr, wc, fr, fq, lds, wid, lane); S.done(cur); }
#undef PG8_SA
#undef PG8_KOFS
#undef PG8_SB
#undef PG8_STAGE
#undef PG8_LDA
#undef PG8_LDB
#undef PG8_MMA
#undef PG8_WAIT_V
#undef PG8_WAIT_L
#undef PG8_BAR
#undef PG8_SCHED
}
}


#define XB_TMO      128
#define XB_XCNT(j)  (256  + 64 * (j))
#define XB_XSUB(j)  (1280 + 64 * (j))
#define XB_XGEN(j)  (2304 + 64 * (j))
#define XB_TOP      3328
#define XB_TOPGEN   3392
#define XCD_BAR_WORDS 3456
#define XB_SPIN_CAP (1u << 18)

__device__ __forceinline__ unsigned xb_ld(unsigned* p)              { return __hip_atomic_load(p, __ATOMIC_RELAXED, __HIP_MEMORY_SCOPE_AGENT); }

__device__ __forceinline__ unsigned xb_add(unsigned* p, unsigned v) { return __hip_atomic_fetch_add(p, v, __ATOMIC_RELAXED, __HIP_MEMORY_SCOPE_AGENT); }
__device__ __forceinline__ unsigned xb_xcc_id() { return (unsigned)__builtin_amdgcn_s_getreg((3 << 11) | 20) & 0xFu; }
#define XB_SPIN(cond, bar) do { unsigned _sp = 0; while (cond) { __builtin_amdgcn_s_sleep(1); \
    if ((++_sp & 255u) == 0u) { if (xb_ld(&(bar)[XB_TMO])) break; if (_sp > XB_SPIN_CAP) { atomicAdd(&(bar)[XB_TMO], 1u); break; } } } } while (0)

struct XcdBarrier {
    unsigned* bar; unsigned x;
    volatile LAS unsigned* st;
};

__device__ __forceinline__ XcdBarrier xcd_barrier_post(unsigned* bar, volatile LAS unsigned* st) {
    XcdBarrier b; b.bar = bar; b.x = xb_xcc_id(); b.st = st;
    if (threadIdx.x == 0) (void)xb_add(&bar[XB_XCNT(b.x)], 1u);
    return b;
}
__device__ __forceinline__ void xcd_barrier_complete(unsigned* bar, unsigned x, unsigned& nloc, unsigned& nx) {
    const unsigned G = gridDim.x * gridDim.y * gridDim.z;
    unsigned sum, cnt, mine, sp = 0u;
    for (;;) {
        sum = 0u; cnt = 0u; mine = 0u;
#pragma unroll
        for (unsigned j = 0; j < 16; ++j) { const unsigned c = xb_ld(&bar[XB_XCNT(j)]); sum += c; cnt += (c > 0u) ? 1u : 0u; mine = (j == x) ? c : mine; }
        if (sum == G) break;
        __builtin_amdgcn_s_sleep(1);
        if ((++sp & 255u) == 0u) { if (xb_ld(&bar[XB_TMO])) break; if (sp > XB_SPIN_CAP) { atomicAdd(&bar[XB_TMO], 1u); break; } }
    }
    nloc = mine > 0u ? mine : 1u; nx = cnt > 0u ? cnt : 1u;
}

__device__ __forceinline__ void xcd_barrier(const XcdBarrier& b) {
    asm volatile("s_waitcnt vmcnt(0)" ::: "memory");
    __syncthreads();
    if (threadIdx.x == 0) {
        unsigned* bar = b.bar;
        __builtin_amdgcn_s_waitcnt(0);
        unsigned nloc = b.st[0], nx = b.st[1];
        if (nloc == 0u) { xcd_barrier_complete(bar, b.x, nloc, nx); b.st[0] = nloc; b.st[1] = nx; }
        const unsigned old = xb_add(&bar[XB_XSUB(b.x)], 1u);
        const unsigned gen = old / nloc;
        if (old + 1u == (gen + 1u) * nloc) {
            __builtin_amdgcn_fence(__ATOMIC_RELEASE, "agent");
            asm volatile("s_waitcnt vmcnt(0)" ::: "memory");
            const unsigned og = xb_add(&bar[XB_TOP], 1u);
            const unsigned tg = og / nx;
            if (og + 1u == (tg + 1u) * nx) xb_add(&bar[XB_TOPGEN], 1u);
            else XB_SPIN(xb_ld(&bar[XB_TOPGEN]) == tg, bar);
            __builtin_amdgcn_fence(__ATOMIC_ACQUIRE, "agent");
            xb_add(&bar[XB_XGEN(b.x)], 1u);
            asm volatile("s_waitcnt vmcnt(0)" ::: "memory");
        } else {
            XB_SPIN(xb_ld(&bar[XB_XGEN(b.x)]) == gen, bar);
            __builtin_amdgcn_fence(__ATOMIC_ACQUIRE, "agent");
            asm volatile("s_waitcnt vmcnt(0)" ::: "memory");
        }
    }
    __syncthreads();
}
constexpr float SSQ_SCALE = 16777216.f, SSQ_INV = 1.f / (16777216.f * 1024.f);
template <int ACT  > struct EpScale {
    static constexpr bool PERM = true, AFTER_DRAIN = false;
    bf16_t* O; int ldo; const unsigned long long* ssq;
    __device__ __forceinline__ u32x2 pack(f32x4 v, float rs) const {
        v = v * rs;
        if (ACT == 1) { v.x = fmaxf(v.x, 0.f); v.y = fmaxf(v.y, 0.f); v.z = fmaxf(v.z, 0.f); v.w = fmaxf(v.w, 0.f); v = v * v; }
        u32x2 o; o.x = cvt_pk_bf16(v.x, v.y); o.y = cvt_pk_bf16(v.z, v.w); return o;
    }
    __device__ __forceinline__ void operator()(const f32x4 (&acc)[2][2][4][2], const pg8::Unit& u, int wr, int wc, int fr, int fq) const {
        const int row0 = u.pm * 256 + wr * 64 + fr, col0 = u.pn * 256 + wc * 32 + 8 * fq;
        unsigned long long sq[2][4];
#pragma unroll
        for (int ai = 0; ai < 2; ++ai)
#pragma unroll
            for (int m = 0; m < 4; ++m) sq[ai][m] = ssq[row0 + ai * 128 + m * 16];
#pragma unroll
        for (int ai = 0; ai < 2; ++ai)
#pragma unroll
            for (int m = 0; m < 4; ++m) {
                const int row = row0 + ai * 128 + m * 16;
                const float rs = rsqrtf((float)sq[ai][m] * SSQ_INV + 1e-6f);
                bf16_t* rp = O + (size_t)row * ldo + col0;
#pragma unroll
                for (int bj = 0; bj < 2; ++bj) {
                    const u32x2 lo = pack(acc[ai][bj][m][0], rs), hi = pack(acc[ai][bj][m][1], rs);
                    u32x4 o; o.x = lo.x; o.y = lo.y; o.z = hi.x; o.w = hi.y;
                    *(u32x4*)(rp + bj * 128) = o;
                }
                asm volatile("" ::: "memory");
            }
    }
    __device__ __forceinline__ void meta(int m, int col, f32x4 v) const {
        const int row = MROWS + m;
        const float rs = rsqrtf((float)ssq[row] * SSQ_INV + 1e-6f);
        *(u32x2*)(O + (size_t)row * ldo + col) = pack(v, rs);
    }
};
struct EpRes {
    static constexpr bool PERM = true, AFTER_DRAIN = false;
    float* hmeta; bf16_t* hb; unsigned long long* ssq_out;
    __device__ __forceinline__ void operator()(const f32x4 (&acc)[2][2][4][2], const pg8::Unit& u, int wr, int wc, int fr, int fq) const {
        const int row0 = u.pm * 256 + wr * 64 + fr, col0 = u.pn * 256 + wc * 32 + 8 * fq;
        u32x4 hn[2];
#pragma unroll
        for (int bj = 0; bj < 2; ++bj) hn[bj] = *(const u32x4*)(hb + (size_t)row0 * 1024 + col0 + bj * 128);
#pragma unroll
        for (int g = 0; g < 8; ++g) {
            const int ai = g >> 2, m = g & 3;
            const int row = row0 + ai * 128 + m * 16;
            const size_t off = (size_t)row * 1024 + col0;
            u32x4 hc[2];
#pragma unroll
            for (int bj = 0; bj < 2; ++bj) hc[bj] = hn[bj];
            if (g < 7) {
                const int ai2 = (g + 1) >> 2, m2 = (g + 1) & 3;
                const size_t off2 = (size_t)(row0 + ai2 * 128 + m2 * 16) * 1024 + col0;
#pragma unroll
                for (int bj = 0; bj < 2; ++bj) hn[bj] = *(const u32x4*)(hb + off2 + bj * 128);
            }
            float s = 0.f;
#pragma unroll
            for (int bj = 0; bj < 2; ++bj) {
                const f32x4 r0 = {bflo(hc[bj].x), bfhi(hc[bj].x), bflo(hc[bj].y), bfhi(hc[bj].y)}, r1 = {bflo(hc[bj].z), bfhi(hc[bj].z), bflo(hc[bj].w), bfhi(hc[bj].w)};
                const f32x4 h0 = r0 + acc[ai][bj][m][0], h1 = r1 + acc[ai][bj][m][1];
                u32x4 p; p.x = cvt_pk_bf16(h0.x, h0.y); p.y = cvt_pk_bf16(h0.z, h0.w); p.z = cvt_pk_bf16(h1.x, h1.y); p.w = cvt_pk_bf16(h1.z, h1.w);
                *(u32x4*)(hb + off + bj * 128) = p;
                s += ((h0.x * h0.x + h0.y * h0.y) + (h0.z * h0.z + h0.w * h0.w)) + ((h1.x * h1.x + h1.y * h1.y) + (h1.z * h1.z + h1.w * h1.w));
            }
            s += __shfl_xor(s, 16); s += __shfl_xor(s, 32);
            if (fq == 0) atomicAdd(ssq_out + row, __float2ull_rn(s * SSQ_SCALE));
        }
    }
    __device__ __forceinline__ void meta(int m, int col, f32x4 v) const {
        float* p = hmeta + m * 1024 + col;
        f32x4 h = *(const f32x4*)p + v;
        *(f32x4*)p = h;
        u32x2 q; q.x = cvt_pk_bf16(h.x, h.y); q.y = cvt_pk_bf16(h.z, h.w);
        *(u32x2*)(hb + (size_t)(MROWS + m) * 1024 + col) = q;
        atomicAdd(ssq_out + MROWS + m, __float2ull_rn(((h.x * h.x + h.y * h.y) + (h.z * h.z + h.w * h.w)) * SSQ_SCALE));
    }
};

template <class Epi>
__device__ __forceinline__ void meta_gemm(float* red  , const bf16_t* A, int lda, const bf16_t* Bt, int N, int K, const Epi& E) {
    const int tid = opaque_tid(), wid = tid >> 6, lane = tid & 63, i16 = lane & 15, quad = lane >> 4;
    const int kper = K / 8;
    for (int tile = opaque_bid(); tile < N / 16; tile += gridDim.x) {
        f32x4 acc = {0.f, 0.f, 0.f, 0.f};
        const bf16_t* ap = A + (size_t)i16 * lda + wid * kper + quad * 8;
        const bf16_t* bp = Bt + (size_t)(tile * 16 + i16) * K + wid * kper + quad * 8;
#pragma unroll 16
        for (int k = 0; k < kper; k += 32) {
            const bf16x8 a = *(const bf16x8*)(ap + k), b = *(const bf16x8*)(bp + k);
            acc = __builtin_amdgcn_mfma_f32_16x16x32_bf16(a, b, acc, 0, 0, 0);
        }
#pragma unroll
        for (int j = 0; j < 4; ++j) red[wid * 256 + (quad * 4 + j) * 16 + i16] = acc[j];
        __syncthreads();
        if (tid < 64) {
            const int row = tid >> 2, c4 = (tid & 3) * 4;
            f32x4 s = {0.f, 0.f, 0.f, 0.f};
#pragma unroll
            for (int w = 0; w < 8; ++w) s += *(const f32x4*)(red + w * 256 + row * 16 + c4);
            E.meta(row, tile * 16 + c4, s);
        }
        __syncthreads();
    }
}

__device__ __forceinline__ void conv_w(float* lds, const float* W, int K, int N, bf16_t* WT, const float* gain, int wg, int nwg) {
    const int tid = opaque_tid(), wid = tid >> 6, lane = tid & 63;
    LAS float* scr = (LAS float*)lds + wid * (64 * 33);
    const int nblk = N / 32, nitems = (K / 64) * nblk;
    const int gw = wg * 8 + wid, nw = nwg * 8;
    for (int item = gw; item < nitems; item += nw) {
        const int kb = item / nblk, nb = item % nblk, k0 = 64 * kb, n0 = 32 * nb;
        float v[32];
#pragma unroll
        for (int i = 0; i < 32; ++i) v[i] = __builtin_nontemporal_load(W + (size_t)(k0 + 2 * i + (lane >> 5)) * N + n0 + (lane & 31));
        if (gain) {
#pragma unroll
            for (int i = 0; i < 32; ++i) v[i] *= gain[k0 + 2 * i + (lane >> 5)];
        }
#pragma unroll
        for (int i = 0; i < 32; ++i) scr[(2 * i + (lane >> 5)) * 33 + (lane & 31)] = v[i];
        __builtin_amdgcn_fence(__ATOMIC_RELEASE, "wavefront"); __builtin_amdgcn_wave_barrier(); __builtin_amdgcn_fence(__ATOMIC_ACQUIRE, "wavefront");
        const int c = lane & 7;
#pragma unroll
        for (int j = 0; j < 4; ++j) {
            const int n = (lane >> 3) + 8 * j; const LAS float* s = scr + (8 * c) * 33 + n;
            u32x4 o; o.x = cvt_pk_bf16(s[0 * 33], s[1 * 33]); o.y = cvt_pk_bf16(s[2 * 33], s[3 * 33]); o.z = cvt_pk_bf16(s[4 * 33], s[5 * 33]); o.w = cvt_pk_bf16(s[6 * 33], s[7 * 33]);
            *(u32x4*)(WT + (size_t)(n0 + n) * K + k0 + 8 * c) = o;
        }
        __builtin_amdgcn_fence(__ATOMIC_RELEASE, "wavefront"); __builtin_amdgcn_wave_barrier(); __builtin_amdgcn_fence(__ATOMIC_ACQUIRE, "wavefront");
    }
}

__device__ __forceinline__ void phase_p0(const Params& p) {
    const int tid = opaque_tid(), wid = tid >> 6, lane = tid & 63;
    const int gw = opaque_bid() * 8 + wid, nw = gridDim.x * 8;
    bf16_t* hb = (bf16_t*)(p.ws + WS_HB); unsigned long long* ssq = (unsigned long long*)(p.ws + WS_SSQ); float* hmeta = (float*)(p.ws + WS_HMETA);
    for (int i = opaque_bid() * NTHREADS + tid; i < 8 * RROWS; i += gridDim.x * NTHREADS) ssq[RROWS + i] = 0ull;
    for (int row = gw; row < RROWS; row += 2 * nw) {
        const int row2 = row + nw; const bool two = row2 < RROWS;
        const float* src = row < MROWS ? p.x + (size_t)row * 1024 : p.meta + (size_t)(row - MROWS) * 1024;
        const float* src2 = !two ? src : (row2 < MROWS ? p.x + (size_t)row2 * 1024 : p.meta + (size_t)(row2 - MROWS) * 1024);
        f32x4 v[4], w[4];
#pragma unroll
        for (int j = 0; j < 4; ++j) { v[j] = *(const f32x4*)(src + j * 256 + lane * 4); w[j] = *(const f32x4*)(src2 + j * 256 + lane * 4); }
        float s = 0.f, s2 = 0.f;
#pragma unroll
        for (int j = 0; j < 4; ++j) {
            s += (v[j].x * v[j].x + v[j].y * v[j].y) + (v[j].z * v[j].z + v[j].w * v[j].w);
            u32x2 q; q.x = cvt_pk_bf16(v[j].x, v[j].y); q.y = cvt_pk_bf16(v[j].z, v[j].w);
            *(u32x2*)(hb + (size_t)row * 1024 + j * 256 + lane * 4) = q;
            if (row >= MROWS) *(f32x4*)(hmeta + (size_t)(row - MROWS) * 1024 + j * 256 + lane * 4) = v[j];
            if (two) {
                s2 += (w[j].x * w[j].x + w[j].y * w[j].y) + (w[j].z * w[j].z + w[j].w * w[j].w);
                u32x2 q2; q2.x = cvt_pk_bf16(w[j].x, w[j].y); q2.y = cvt_pk_bf16(w[j].z, w[j].w);
                *(u32x2*)(hb + (size_t)row2 * 1024 + j * 256 + lane * 4) = q2;
                if (row2 >= MROWS) *(f32x4*)(hmeta + (size_t)(row2 - MROWS) * 1024 + j * 256 + lane * 4) = w[j];
            }
        }
        s = sum64(s); s2 = sum64(s2);
        if (lane == 0) { ssq[row] = __float2ull_rn(s * SSQ_SCALE); if (two) ssq[row2] = __float2ull_rn(s2 * SSQ_SCALE); }
    }
}
__device__ __forceinline__ void phase_final(const Params& p) {
    const int tid = opaque_tid(), wid = tid >> 6, lane = tid & 63;
    const int gw = opaque_bid() * 8 + wid, nw = gridDim.x * 8;
    const unsigned long long* ssq = (const unsigned long long*)(p.ws + WS_SSQ) + (size_t)8 * RROWS;
    f32x4 g[4];
#pragma unroll
    for (int j = 0; j < 4; ++j) g[j] = *(const f32x4*)(p.final_norm + j * 256 + lane * 4);
    const bf16_t* hb = (const bf16_t*)(p.ws + WS_HB);
    for (int row = gw; row < MROWS; row += 4 * nw) {
        u32x2 v[4][4]; float rs[4];
#pragma unroll
        for (int r = 0; r < 4; ++r) {
            const int rr = row + r * nw;
            if (rr < MROWS) {
                rs[r] = rsqrtf((float)ssq[rr] * SSQ_INV + 1e-6f);
#pragma unroll
                for (int j = 0; j < 4; ++j) v[r][j] = *(const u32x2*)(hb + (size_t)rr * 1024 + j * 256 + lane * 4);
            }
        }
#pragma unroll
        for (int r = 0; r < 4; ++r) {
            const int rr = row + r * nw;
            if (rr < MROWS) {
#pragma unroll
                for (int j = 0; j < 4; ++j) {
                    const f32x4 h = {bflo(v[r][j].x), bfhi(v[r][j].x), bflo(v[r][j].y), bfhi(v[r][j].y)};
                    *(f32x4*)(p.out + (size_t)rr * 1024 + j * 256 + lane * 4) = h * rs[r] * g[j];
                }
            }
        }
    }
}
constexpr int PP_PS = 0;
constexpr int PS_LD = 1156;
constexpr int PP_ACT = PP_PS + 16 * PS_LD * 4;
constexpr int PP_VA = PP_ACT + 16 * 136 * 2;
constexpr int PP_PART = PP_VA + 16 * 392 * 2;
constexpr int PP_VLO = PP_PART + 6 * 256 * 4;
constexpr int PP_SLB = PP_VLO + 16 * 40 * 2;
constexpr int PP_CST = PP_SLB + 1024;
constexpr int PP_END = PP_CST + 6 * 384 * 4;
static_assert(PP_END <= LDS_BYTES, "prep LDS");
__device__ __forceinline__ bf16x8 ld_bfrag(const float* W, int ldw, int k0, int kmax, int c) {
    float f[8];
#pragma unroll
    for (int e = 0; e < 8; ++e) f[e] = (k0 + e) < kmax ? W[(size_t)(k0 + e) * ldw + c] : 0.f;
    u32x4 o; o.x = cvt_pk_bf16(f[0], f[1]); o.y = cvt_pk_bf16(f[2], f[3]); o.z = cvt_pk_bf16(f[4], f[5]); o.w = cvt_pk_bf16(f[6], f[7]);
    return __builtin_bit_cast(bf16x8, o);
}
__device__ __forceinline__ void phase_prep(const Params& p, unsigned char* ldsb, int l) {
    const int tid = opaque_tid();
    float* ps = (float*)(ldsb + PP_PS);
    bf16_t* act = (bf16_t*)(ldsb + PP_ACT); bf16_t* vA = (bf16_t*)(ldsb + PP_VA);
    float* part = (float*)(ldsb + PP_PART); bf16_t* vloA = (bf16_t*)(ldsb + PP_VLO); float* slb = (float*)(ldsb + PP_SLB);
    bf16_t* proj = (bf16_t*)(p.ws + WS_PROJ);
    bf16_t* PS = (bf16_t*)(p.ws + WS_PS); bf16_t* PV = (bf16_t*)(p.ws + WS_PV); bf16_t* PG = (bf16_t*)(p.ws + WS_PG); bf16_t* VF = (bf16_t*)(p.ws + WS_VF);
    float* BONUS = (float*)(p.ws + WS_BONUS);
    const float* mu = p.b_mu + l * BCOLS;
    if (tid < 256) {
        float v[4], m = -1e30f;
#pragma unroll
        for (int i = 0; i < 4; ++i) { v[i] = p.c_lb[i * 256 + tid]; m = fmaxf(m, v[i]); }
        float den = 0.f, num = 0.f;
#pragma unroll
        for (int i = 0; i < 4; ++i) { const float e = __expf(v[i] - m); den += e; if (i >= 1 && i <= l) num += e; }
        slb[tid] = num / den;
    }
    float* cst = (float*)(ldsb + PP_CST);
    for (int i = tid; i < 6 * 384; i += NTHREADS) {
        const int k = i / 384, c = i % 384;
        const float* src = k == 0 ? p.b_w0 : k == 1 ? p.b_a0 : k == 2 ? p.b_k_k : k == 3 ? p.b_k_a : k == 4 ? p.b_r_k : p.b_v0;
        cst[i] = (k == 5) ? (l > 0 ? src[(l - 1) * 384 + c] : 0.f) : src[l * 384 + c];
    }
    if (tid < 256) vloA[(tid >> 4) * 40 + 16 + (tid & 15)] = 0;
    bf16x8 Bw[4], Ba[4], Bg0[4], Bg1[4], Bv2[4], Bv1[2];
#pragma unroll
    for (int ct = 0; ct < 4; ++ct) { Bw[ct] = Ba[ct] = Bg0[ct] = Bg1[ct] = Bv2[ct] = (bf16x8){0, 0, 0, 0, 0, 0, 0, 0}; }
    Bv1[0] = Bv1[1] = (bf16x8){0, 0, 0, 0, 0, 0, 0, 0};
    const int wid0 = tid >> 6, n160 = tid & 15, quad0 = (tid >> 4) & 3;
    if (wid0 < 6) {
        const float* w2 = p.b_w2 + (size_t)l * 32 * 384; const float* a2 = p.b_a2 + (size_t)l * 32 * 384; const float* g2 = p.b_g2 + (size_t)l * 64 * 384;
#pragma unroll
        for (int ct = 0; ct < 4; ++ct) {
            const int c = wid0 * 64 + (ct >> 1) * 32 + (n160 >> 2) * 8 + (ct & 1) * 4 + (n160 & 3);
            Bw[ct] = ld_bfrag(w2, 384, quad0 * 8, 32, c); Ba[ct] = ld_bfrag(a2, 384, quad0 * 8, 32, c);
            Bg0[ct] = ld_bfrag(g2, 384, quad0 * 8, 64, c); Bg1[ct] = ld_bfrag(g2, 384, 32 + quad0 * 8, 64, c);
            if (l > 0) Bv2[ct] = ld_bfrag(p.b_v2 + (size_t)(l - 1) * 16 * 384, 384, quad0 * 8, 16, c);
        }
        if (l > 0) {
            const float* v1 = p.b_v1 + (size_t)(l - 1) * 384 * 16;
            Bv1[0] = ld_bfrag(v1, 16, wid0 * 64 + quad0 * 8, 384, n160); Bv1[1] = ld_bfrag(v1, 16, wid0 * 64 + 32 + quad0 * 8, 384, n160);
        }
    }
    __syncthreads();
    const int nmain_it = (1024 - opaque_bid() + (int)gridDim.x - 1) / (int)gridDim.x;
    for (int it = 0; it < nmain_it + (opaque_bid() < 6 ? 1 : 0); ++it) {
        const int tile = it < nmain_it ? opaque_bid() + it * (int)gridDim.x : 1024;
        const int hsel = tile == 1024 ? opaque_bid() : -1;
        const int row0 = tile * 16;
        int tidl = tid; asm volatile("" : "+v"(tidl));
        const int wid = tidl >> 6, n16 = tidl & 15, quad = (tidl >> 4) & 3;
        u32x4 cu5[5], pu5[5];
#pragma unroll
        for (int i = 0; i < 5; ++i) {
            const int q = tidl + i * NTHREADS, tok = q / 160, cc = (q % 160) * 8, row = row0 + tok;
            int prow;
            if (tile == 1024) prow = tok == 0 ? -1 : row - 1;
            else prow = (row & (SEQ - 1)) == 0 ? MROWS + NMETA - 1 : row - 1;
            cu5[i] = *(const u32x4*)(proj + (size_t)row * NIN + PC_B + cc);
            pu5[i] = (u32x4){0u, 0u, 0u, 0u};
            if (prow >= 0) pu5[i] = *(const u32x4*)(proj + (size_t)prow * NIN + PC_B + cc);
        }
#pragma unroll
        for (int i = 0; i < 5; ++i) {
            const int q = tidl + i * NTHREADS, tok = q / 160, cc = (q % 160) * 8;
            float c[8], pv[8]; unpack8(cu5[i], c); unpack8(pu5[i], pv);
            const f32x4 m0 = *(const f32x4*)(mu + cc), m1 = *(const f32x4*)(mu + cc + 4);
            float o[8];
            o[0] = c[0] + m0.x * (pv[0] - c[0]); o[1] = c[1] + m0.y * (pv[1] - c[1]); o[2] = c[2] + m0.z * (pv[2] - c[2]); o[3] = c[3] + m0.w * (pv[3] - c[3]);
            o[4] = c[4] + m1.x * (pv[4] - c[4]); o[5] = c[5] + m1.y * (pv[5] - c[5]); o[6] = c[6] + m1.z * (pv[6] - c[6]); o[7] = c[7] + m1.w * (pv[7] - c[7]);
            if (cc < 1152) {
                *(f32x4*)(ps + tok * PS_LD + cc) = (f32x4){o[0], o[1], o[2], o[3]}; *(f32x4*)(ps + tok * PS_LD + cc + 4) = (f32x4){o[4], o[5], o[6], o[7]};
                if (cc >= 768) { u32x4 b; b.x = cvt_pk_bf16(o[0], o[1]); b.y = cvt_pk_bf16(o[2], o[3]); b.z = cvt_pk_bf16(o[4], o[5]); b.w = cvt_pk_bf16(o[6], o[7]); *(u32x4*)(vA + tok * 392 + (cc - 768)) = b; }
            } else {
                if (cc < 1184) {
#pragma unroll
                    for (int e = 0; e < 8; ++e) o[e] = tanhf_(o[e]);
                } else if (cc >= 1216) {
#pragma unroll
                    for (int e = 0; e < 8; ++e) o[e] = sigmoidf_(o[e]);
                }
                u32x4 b; b.x = cvt_pk_bf16(o[0], o[1]); b.y = cvt_pk_bf16(o[2], o[3]); b.z = cvt_pk_bf16(o[4], o[5]); b.w = cvt_pk_bf16(o[6], o[7]);
                *(u32x4*)(act + tok * 136 + (cc - 1152)) = b;
            }
            asm volatile("" ::: "memory");
        }
        __syncthreads();
        if (l > 0) {
            if (wid < 6) {
                const bf16x8 a0 = *(const bf16x8*)(vA + n16 * 392 + wid * 64 + quad * 8), a1 = *(const bf16x8*)(vA + n16 * 392 + wid * 64 + 32 + quad * 8);
                f32x4 acc = {0.f, 0.f, 0.f, 0.f};
                acc = __builtin_amdgcn_mfma_f32_16x16x32_bf16(Bv1[0], a0, acc, 0, 0, 0);
                acc = __builtin_amdgcn_mfma_f32_16x16x32_bf16(Bv1[1], a1, acc, 0, 0, 0);
                *(f32x4*)(part + wid * 256 + n16 * 16 + quad * 4) = acc;
            }
            __syncthreads();
            if (tidl < 256) {
                float s = 0.f;
#pragma unroll
                for (int w = 0; w < 6; ++w) s += part[w * 256 + tidl];
                vloA[(tidl >> 4) * 40 + (tidl & 15)] = f2bf(s);
            }
            __syncthreads();
        }
        if (wid < 6 && (hsel < 0 || wid == hsel)) {
            const int h = wid, tok = n16; const unsigned row = (unsigned)(row0 + tok);
            const bf16x8 aw = *(const bf16x8*)(act + n16 * 136 + quad * 8), aa = *(const bf16x8*)(act + n16 * 136 + 32 + quad * 8);
            const bf16x8 ag0 = *(const bf16x8*)(act + n16 * 136 + 64 + quad * 8), ag1 = *(const bf16x8*)(act + n16 * 136 + 96 + quad * 8);
            const bf16x8 av = *(const bf16x8*)(vloA + n16 * 40 + quad * 8);
            float ssq = 0.f, bon = 0.f;
#pragma unroll
            for (int ct = 0; ct < 4; ++ct) {
                const int c = h * 64 + (ct >> 1) * 32 + quad * 8 + (ct & 1) * 4;
                const f32x4 kr = *(const f32x4*)(ps + tok * PS_LD + 384 + c) * *(const f32x4*)(cst + 768 + c);
                ssq += (kr.x * kr.x + kr.y * kr.y) + (kr.z * kr.z + kr.w * kr.w);
            }
            ssq += __shfl_xor(ssq, 16); ssq += __shfl_xor(ssq, 32);
            const float inv = 1.f / fmaxf(sqrtf(ssq), 1e-12f);
            u32x2 e_omw = {0u, 0u}, e_kmod = {0u, 0u}, e_rp = {0u, 0u}, e_v = {0u, 0u}, e_g = {0u, 0u}, e_kk = {0u, 0u}, e_ka = {0u, 0u};
            u32x2 vfr4[4];
#pragma unroll
            for (int ct = 0; ct < 4; ++ct) { vfr4[ct] = (u32x2){0u, 0u}; if (l > 0) vfr4[ct] = *(const u32x2*)(VF + row * 384 + h * 64 + (ct >> 1) * 32 + quad * 8 + (ct & 1) * 4); }
            bf16_t* psrow = PS + (row * 6 + h) * 256;
            float* wtl = p.out + WTL_F + ((size_t)tile * 6 + h) * 64;
#pragma unroll
            for (int ct = 0; ct < 4; ++ct) {
                int c = h * 64 + (ct >> 1) * 32 + quad * 8 + (ct & 1) * 4; asm volatile("" : "+v"(c));
                const int cl = (ct >> 1) * 32 + quad * 8;
                const f32x4 z = {0.f, 0.f, 0.f, 0.f};
                const f32x4 cw = __builtin_amdgcn_mfma_f32_16x16x32_bf16(Bw[ct], aw, z, 0, 0, 0);
                const f32x4 ca = __builtin_amdgcn_mfma_f32_16x16x32_bf16(Ba[ct], aa, z, 0, 0, 0);
                f32x4 cg = __builtin_amdgcn_mfma_f32_16x16x32_bf16(Bg0[ct], ag0, z, 0, 0, 0);
                cg = __builtin_amdgcn_mfma_f32_16x16x32_bf16(Bg1[ct], ag1, cg, 0, 0, 0);
                f32x4 cv = z;
                if (l > 0) cv = __builtin_amdgcn_mfma_f32_16x16x32_bf16(Bv2[ct], av, z, 0, 0, 0);
                const f32x4 w0 = *(const f32x4*)(cst + c), a0 = *(const f32x4*)(cst + 384 + c), kk_ = *(const f32x4*)(cst + 768 + c);
                const f32x4 ka_ = *(const f32x4*)(cst + 1152 + c), rk_ = *(const f32x4*)(cst + 1536 + c), v0 = *(const f32x4*)(cst + 1920 + c);
                const f32x4 rp = *(const f32x4*)(ps + tok * PS_LD + c), kp = *(const f32x4*)(ps + tok * PS_LD + 384 + c), vp = *(const f32x4*)(ps + tok * PS_LD + 768 + c);
                f32x4 omw, a, v = vp;
#pragma unroll
                for (int j = 0; j < 4; ++j) {
                    const float x = w0[j] + cw[j];
                    const float sp = fmaxf(-x, 0.f) + __logf(1.f + __expf(-fabsf(x)));
                    omw[j] = 1.f - __expf(-__expf(-sp - 0.5f));
                    a[j] = sigmoidf_(a0[j] + ca[j]);
                }
                if (l == 0) { u32x2 o; o.x = cvt_pk_bf16(vp.x, vp.y); o.y = cvt_pk_bf16(vp.z, vp.w); *(u32x2*)(VF + row * 384 + c) = o; }
                else {
                    const u32x2 vfr = vfr4[ct];
                    const f32x4 vf = {bflo(vfr.x), bfhi(vfr.x), bflo(vfr.y), bfhi(vfr.y)};
#pragma unroll
                    for (int j = 0; j < 4; ++j) v[j] = vp[j] + (vf[j] - vp[j]) * sigmoidf_(v0[j] + cv[j]);
                }
                const f32x4 kmod0 = kp * (1.f + (a - 1.f) * ka_);
                const f32x4 kr = kp * kk_;
                const f32x4 kk0 = kr * inv, kka0 = kk0 * a;
                const f32x4 bt = rp * kmod0 * rk_;
                bon += (bt.x + bt.y) + (bt.z + bt.w);
                f32x4 W, Wp;
#pragma unroll
                for (int j = 0; j < 4; ++j) {
                    float x = 1.f - omw[j];
                    x *= dppf1<0x111>(x); x *= dppf1<0x112>(x); x *= dppf1<0x114>(x); x *= dppf1<0x118>(x);
                    W[j] = x; Wp[j] = dppf1<0x111>(x);
                }
                f32x4 Wi; Wi.x = rcpf_(W.x); Wi.y = rcpf_(W.y); Wi.z = rcpf_(W.z); Wi.w = rcpf_(W.w);
                const f32x4 kk = kk0 * Wp, kka = kka0 * Wi, kmod = kmod0 * Wi, rps = rp * W;
                omw = W;
                u32x2 o_omw, o_kmod, o_rp, o_v, o_g, o_kk, o_ka;
                o_kk.x = cvt_pk_bf16(kk.x, kk.y); o_kk.y = cvt_pk_bf16(kk.z, kk.w); o_ka.x = cvt_pk_bf16(kka.x, kka.y); o_ka.y = cvt_pk_bf16(kka.z, kka.w);
                o_omw.x = cvt_pk_bf16(omw.x, omw.y); o_omw.y = cvt_pk_bf16(omw.z, omw.w);
                o_kmod.x = cvt_pk_bf16(kmod.x, kmod.y); o_kmod.y = cvt_pk_bf16(kmod.z, kmod.w);
                o_rp.x = cvt_pk_bf16(rps.x, rps.y); o_rp.y = cvt_pk_bf16(rps.z, rps.w);
                o_v.x = cvt_pk_bf16(v.x, v.y); o_v.y = cvt_pk_bf16(v.z, v.w);
                o_g.x = cvt_pk_bf16(cg.x, cg.y); o_g.y = cvt_pk_bf16(cg.z, cg.w);
                if (tok == 15) *(f32x4*)(wtl + cl + (ct & 1) * 4) = W;
                if ((ct & 1) == 0) { e_omw = o_omw; e_kmod = o_kmod; e_rp = o_rp; e_v = o_v; e_g = o_g; e_kk = o_kk; e_ka = o_ka; }
                else {
                    *(u32x4*)(psrow + 0 + cl) = (u32x4){e_kk.x, e_kk.y, o_kk.x, o_kk.y};
                    *(u32x4*)(psrow + 64 + cl) = (u32x4){e_ka.x, e_ka.y, o_ka.x, o_ka.y};
                    *(u32x4*)(psrow + 128 + cl) = (u32x4){e_kmod.x, e_kmod.y, o_kmod.x, o_kmod.y};
                    *(u32x4*)(psrow + 192 + cl) = (u32x4){e_rp.x, e_rp.y, o_rp.x, o_rp.y};
                    *(u32x4*)(PV + row * 384 + h * 64 + cl) = (u32x4){e_v.x, e_v.y, o_v.x, o_v.y};
                    *(u32x4*)(PG + row * 384 + h * 64 + cl) = (u32x4){e_g.x, e_g.y, o_g.x, o_g.y};
                }
                asm volatile("" ::: "memory");
                __builtin_amdgcn_sched_barrier(0);
            }
            bon += __shfl_xor(bon, 16); bon += __shfl_xor(bon, 32);
            if (quad == 0) BONUS[row * 8 + h] = bon;
        } else if (wid >= 6 && hsel <= 0) {
            const int t2 = tidl - 384, tok = t2 & 15, g = t2 >> 4;
            bf16_t* rowp = proj + (size_t)(row0 + tok) * NIN;
            float* acb = p.out + ACB_F + (size_t)tile * 256;
            u32x4 rq[4], rf[4];
#pragma unroll
            for (int i = 0; i < 4; ++i) { rq[i] = *(const u32x4*)(rowp + PC_Q + g * 32 + i * 8); rf[i] = *(const u32x4*)(rowp + PC_FZ + g * 32 + i * 8); }
#pragma unroll
            for (int i = 0; i < 4; ++i) {
                float fq_[8], ff_[8]; unpack8(rq[i], fq_); unpack8(rf[i], ff_);
#pragma unroll
                for (int e = 0; e < 8; ++e) {
                    const int c = g * 32 + i * 8 + e;
                    const float lb = slb[c];
                    const float kk = (1.f - lb) * (1.f - sigmoidf_(ff_[e]));
                    float a_ = 1.f - kk;
                    a_ *= dppf1<0x111>(a_); a_ *= dppf1<0x112>(a_); a_ *= dppf1<0x114>(a_); a_ *= dppf1<0x118>(a_);
                    a_ = fmaxf(a_, 1e-30f);
                    if (tok == 15) acb[c] = a_;
                    fq_[e] = siluf_(fq_[e]) * a_;
                    ff_[e] = kk * rcpf_(a_);
                }
                u32x4 o; o.x = cvt_pk_bf16(fq_[0], fq_[1]); o.y = cvt_pk_bf16(fq_[2], fq_[3]); o.z = cvt_pk_bf16(fq_[4], fq_[5]); o.w = cvt_pk_bf16(fq_[6], fq_[7]);
                *(u32x4*)(rowp + PC_Q + g * 32 + i * 8) = o;
                o.x = cvt_pk_bf16(ff_[0], ff_[1]); o.y = cvt_pk_bf16(ff_[2], ff_[3]); o.z = cvt_pk_bf16(ff_[4], ff_[5]); o.w = cvt_pk_bf16(ff_[6], ff_[7]);
                *(u32x4*)(rowp + PC_FZ + g * 32 + i * 8) = o;
            }
        }
        __syncthreads();
    }
}
constexpr int SB_TOK = 256, SB_BUF = 16 * SB_TOK;
constexpr int SC_TOK = 128, SC_BUF = 16 * SC_TOK;
template <int VAR, int MODE = 0>
__device__ __forceinline__ void scan_bc(const Params& p, float* lds, int slot, int l) {
    const int tid = opaque_tid(), half = tid >> 8, t2 = tid & 255, r = t2 >> 4, ks = t2 & 15;
    float* sb = lds;
    float* sv = sb + 2 * SB_BUF;
    float* sy = sv + 2 * 256;
    float* swd = sy + 2 * 256;
    float* sc = sy + 2 * 256;
    float* si = sc + 2 * SC_BUF;
    float* so = si + 2 * 256;
    float* slb = so + 2 * 256;
    const bf16_t* proj = (const bf16_t*)(p.ws + WS_PROJ);
    float* projf = (float*)(p.ws + WS_PROJ);
    const bf16_t* PS = (const bf16_t*)(p.ws + WS_PS); const bf16_t* PV = (const bf16_t*)(p.ws + WS_PV);
    float* YRAW = p.out;
    const int bb = (slot >> 2) / 6, bh = (slot >> 2) % 6, rg = slot & 3;
    const int cunit = slot * 2 + half;
    const bool hasc = (VAR == 0) && (MODE == 1) && cunit < 32;
    const int cb = cunit >> 2, ch = cunit & 3, vg = t2 >> 6, cl_ = t2 & 63, cn = cl_ & 15, cq4 = cl_ >> 4;
    bf16_t* cbase = (bf16_t*)((unsigned char*)lds + half * 45056);
    constexpr int QLD = 72, VLD = 40, CQP = 0, CKP = 16 * QLD, CIP = 2 * 16 * QLD, CKH = CIP + 64 * VLD, CIV = CKH + 64 * VLD, CAC = CIV + 64 * VLD, CB_EL = CAC + 128;
    const int ub = MODE == 0 ? bb : cb;
    if (hasc) { for (int i = t2; i < 2 * CB_EL / 8; i += 256) *(u32x4*)(cbase + i * 8) = (u32x4){0u, 0u, 0u, 0u}; }
    __syncthreads();
    u32x4 preA[3]; u32x4 prevA = {0u, 0u, 0u, 0u}; u32x4 preK[2] = {{0u, 0u, 0u, 0u}, {0u, 0u, 0u, 0u}};
    f32x4 cS[4] = {{0.f, 0.f, 0.f, 0.f}, {0.f, 0.f, 0.f, 0.f}, {0.f, 0.f, 0.f, 0.f}, {0.f, 0.f, 0.f, 0.f}};
    f32x2 Sa = {0.f, 0.f}, Sb = {0.f, 0.f};
#define SCAN_ROW(tile, tok) ((tile) == 0 ? MROWS + (tok) : ub * SEQ + ((tile) - 1) * 16 + (tok))
    auto issue = [&](int tile, u32x4 (&pre)[3], u32x4& prev_) __attribute__((always_inline)) {
        if (MODE == 0 && half == 0) {
#pragma unroll
            for (int i = 0; i < 2; ++i) { const int q = t2 + i * 256, tok = q >> 5, w = q & 31; pre[i] = *(const u32x4*)(PS + ((size_t)SCAN_ROW(tile, tok) * 6 + bh) * 256 + w * 8); }
            if (t2 < 48) {
                const int tok = t2 >> 1, h8 = t2 & 1, tgl = tile == 0 ? 1024 : bb * 128 + tile - 1;
                const void* src = t2 < 32 ? (const void*)(PV + (size_t)SCAN_ROW(tile, tok & 15) * 384 + bh * 64 + rg * 16 + h8 * 8) : (const void*)(p.out + WTL_F + ((size_t)tgl * 6 + bh) * 64 + (t2 - 32) * 4);
                prev_ = *(const u32x4*)src;
            }
        } else if (hasc) {
            const int tgl = tile == 0 ? 1024 : cb * 128 + tile - 1;
#pragma unroll
            for (int i = 0; i < 2; ++i) {
                const int q = t2 + i * 256;
                if (q < 384) {
                    const int kind = q >> 7, j = q & 127, tok = j & 15, part = j >> 4;
                    const int col = (kind == 0 ? PC_Q : (kind == 1 ? PC_FZ : PC_I)) + ch * 64 + part * 8;
                    pre[i] = *(const u32x4*)(proj + (size_t)SCAN_ROW(tile, tok) * NIN + col);
                    if (kind == 1) { const float* ac = p.out + ACB_F + (size_t)tgl * 256 + ch * 64 + part * 8; preK[0] = *(const u32x4*)ac; preK[1] = *(const u32x4*)(ac + 4); }
                } else if (q < 400) {
                    pre[i] = *(const u32x4*)(p.out + ACB_F + (size_t)tgl * 256 + ch * 64 + (q - 384) * 4);
                }
            }
        }
    };
    auto commit = [&](int buf, u32x4 (&pre)[3], u32x4& prev_) __attribute__((always_inline)) {
        if (MODE == 0 && half == 0) {
#pragma unroll
            for (int i = 0; i < 2; ++i) {
                const int q = t2 + i * 256, tok = q >> 5, w = q & 31; float f[8]; unpack8(pre[i], f);
                if (w >= 8 && w < 16) {
#pragma unroll
                    for (int e = 0; e < 8; ++e) f[e] = -f[e];
                }
                float* d = sb + buf * SB_BUF + tok * SB_TOK + w * 8;
                *(f32x4*)d = (f32x4){f[0], f[1], f[2], f[3]}; *(f32x4*)(d + 4) = (f32x4){f[4], f[5], f[6], f[7]};
            }
            if (t2 < 32) {
                const int tok = t2 >> 1, h8 = t2 & 1; float f[8]; unpack8(prev_, f);
                float* d = sv + buf * 256 + tok * 16 + h8 * 8;
                *(f32x4*)d = (f32x4){f[0], f[1], f[2], f[3]}; *(f32x4*)(d + 4) = (f32x4){f[4], f[5], f[6], f[7]};
            } else if (t2 < 48) {
                *(u32x4*)(swd + buf * 64 + (t2 - 32) * 4) = prev_;
            }
        } else if (hasc) {
            bf16_t* cb_ = cbase + buf * CB_EL;
#pragma unroll
            for (int i = 0; i < 2; ++i) {
                const int q = t2 + i * 256;
                if (q < 384) {
                    const int kind = q >> 7, j = q & 127, tok = j & 15, part = j >> 4;
                    if (kind < 2) {
                        const int kt = part >> 1, s2 = kt >> 1, e0 = (kt & 1) * 4, q0 = (part & 1) * 2;
                        bf16_t* d = cb_ + (kind == 0 ? CQP : CKP) + tok * QLD + (s2 * 4 + q0) * 8 + e0;
                        *(u32x2*)d = (u32x2){pre[i].x, pre[i].y}; *(u32x2*)(d + 8) = (u32x2){pre[i].z, pre[i].w};
                        if (kind == 1) {
                            float f[8]; unpack8(pre[i], f);
                            const f32x4 a0 = __builtin_bit_cast(f32x4, preK[0]), a1 = __builtin_bit_cast(f32x4, preK[1]);
                            const float ac[8] = {a0.x, a0.y, a0.z, a0.w, a1.x, a1.y, a1.z, a1.w};
#pragma unroll
                            for (int e = 0; e < 8; ++e) cb_[CKH + (part * 8 + e) * VLD + (tok >> 3) * 8 + (tok & 7)] = f2bf(f[e] * ac[e]);
                        }
                    } else {
                        const unsigned short h8[8] = {(unsigned short)(pre[i].x & 0xffffu), (unsigned short)(pre[i].x >> 16), (unsigned short)(pre[i].y & 0xffffu), (unsigned short)(pre[i].y >> 16),
                                                      (unsigned short)(pre[i].z & 0xffffu), (unsigned short)(pre[i].z >> 16), (unsigned short)(pre[i].w & 0xffffu), (unsigned short)(pre[i].w >> 16)};
#pragma unroll
                        for (int e = 0; e < 8; ++e) {
                            const int v = part * 8 + e;
                            cb_[CIP + v * VLD + (tok >> 2) * 8 + (tok & 3)] = h8[e];
                            cb_[CIV + v * VLD + (tok >> 3) * 8 + (tok & 7)] = h8[e];
                        }
                    }
                } else if (q < 400) {
                    *(u32x4*)(cb_ + CAC + (q - 384) * 8) = pre[i];
                }
            }
        }
    };
    issue(0, preA, prevA); commit(0, preA, prevA);
    __syncthreads();
    for (int tile = 0; tile < 129; ++tile) {
        const int buf = tile & 1;
        if (VAR != 4 && tile + 1 < 129) issue(tile + 1, preA, prevA);
        if (MODE == 0 && half == 0) {
            const float* T = sb + buf * SB_BUF + ks * 4;
            const float* V = sv + buf * 256 + r;
            f32x4 rkk[3], rka[3], rkx[3], rrr[3]; float rv[3];
            const f32x4 wend = *(const f32x4*)(swd + buf * 64 + ks * 4);
#pragma unroll
            for (int i = 0; i < 2; ++i) { const float* Tn = T + i * SB_TOK; rkk[i] = *(const f32x4*)(Tn); rka[i] = *(const f32x4*)(Tn + 64); rkx[i] = *(const f32x4*)(Tn + 128); rrr[i] = *(const f32x4*)(Tn + 192); rv[i] = V[i * 16]; }
            float ykeep = 0.f, yp = 0.f;
#pragma unroll
            for (int tok = 0; tok < 16; ++tok) {
                const int cs = tok % 3, ns = (tok + 2) % 3;
                if (tok < 14) {
                    const float* Tn = T + (tok + 2) * SB_TOK;
                    if (VAR != 3) { rkk[ns] = *(const f32x4*)(Tn); rka[ns] = *(const f32x4*)(Tn + 64); rkx[ns] = *(const f32x4*)(Tn + 128); rrr[ns] = *(const f32x4*)(Tn + 192);
                    rv[ns] = V[(tok + 2) * 16]; }
                }
                const f32x4 kk = rkk[cs], nk_ = rka[cs], kx = rkx[cs], rr = rrr[cs]; const float vv = rv[cs];
                f32x2 P = Sa * kk.xy; P = Sb * kk.zw + P;
                float d = P.x + P.y;
                const f32x2 Ta = vv * kx.xy + Sa, Tb = vv * kx.zw + Sb;
                if (VAR != 2) d = sum16(d);
                if (tok > 0) { const float y = (VAR != 2) ? sum16(yp) : yp; ykeep = (ks == tok - 1) ? y : ykeep; }
                Sa = d * nk_.xy + Ta; Sb = d * nk_.zw + Tb;
                f32x2 Q = Sa * rr.xy; Q = Sb * rr.zw + Q;
                yp = Q.x + Q.y;
            }
            { const float y = sum16(yp); ykeep = (ks == 15) ? y : ykeep; }
            Sa = Sa * wend.xy; Sb = Sb * wend.zw;
            sy[buf * 256 + ks * 16 + r] = ykeep;
        } else if (hasc) {
            const bf16_t* cb_ = cbase + buf * CB_EL;
            const bf16x8 qf0 = *(const bf16x8*)(cb_ + CQP + cn * QLD + (0 * 4 + cq4) * 8), qf1 = *(const bf16x8*)(cb_ + CQP + cn * QLD + (1 * 4 + cq4) * 8);
            const bf16x8 kf0 = *(const bf16x8*)(cb_ + CKP + cn * QLD + (0 * 4 + cq4) * 8), kf1 = *(const bf16x8*)(cb_ + CKP + cn * QLD + (1 * 4 + cq4) * 8);
            const bf16x8 ipf = *(const bf16x8*)(cb_ + CIP + (vg * 16 + cn) * VLD + cq4 * 8), ivf = *(const bf16x8*)(cb_ + CIV + (vg * 16 + cn) * VLD + cq4 * 8);
            u32x4 sp;
            sp.x = cvt_pk_bf16(cS[0].x, cS[0].y); sp.y = cvt_pk_bf16(cS[0].z, cS[0].w); sp.z = cvt_pk_bf16(cS[1].x, cS[1].y); sp.w = cvt_pk_bf16(cS[1].z, cS[1].w);
            const bf16x8 sf0 = __builtin_bit_cast(bf16x8, sp);
            sp.x = cvt_pk_bf16(cS[2].x, cS[2].y); sp.y = cvt_pk_bf16(cS[2].z, cS[2].w); sp.z = cvt_pk_bf16(cS[3].x, cS[3].y); sp.w = cvt_pk_bf16(cS[3].z, cS[3].w);
            const bf16x8 sf1 = __builtin_bit_cast(bf16x8, sp);
            f32x4 o = {0.f, 0.f, 0.f, 0.f}, att = {0.f, 0.f, 0.f, 0.f};
            o = __builtin_amdgcn_mfma_f32_16x16x32_bf16(sf0, qf0, o, 0, 0, 0);
            o = __builtin_amdgcn_mfma_f32_16x16x32_bf16(sf1, qf1, o, 0, 0, 0);
            att = __builtin_amdgcn_mfma_f32_16x16x32_bf16(kf0, qf0, att, 0, 0, 0);
            att = __builtin_amdgcn_mfma_f32_16x16x32_bf16(kf1, qf1, att, 0, 0, 0);
            att.x = (4 * cq4 + 0 <= cn) ? att.x : 0.f; att.y = (4 * cq4 + 1 <= cn) ? att.y : 0.f; att.z = (4 * cq4 + 2 <= cn) ? att.z : 0.f; att.w = (4 * cq4 + 3 <= cn) ? att.w : 0.f;
            sp.x = cvt_pk_bf16(att.x, att.y); sp.y = cvt_pk_bf16(att.z, att.w); sp.z = 0u; sp.w = 0u;
            o = __builtin_amdgcn_mfma_f32_16x16x32_bf16(ipf, __builtin_bit_cast(bf16x8, sp), o, 0, 0, 0);
            if (tile > 0 || cb == 0) *(f32x4*)(projf + (size_t)SCAN_ROW(tile, cn) * 1536 + ORAW_F + ch * 64 + vg * 16 + 4 * cq4) = o;
            const float* acs = (const float*)(cb_ + CAC);
#pragma unroll
            for (int kt = 0; kt < 4; ++kt) {
                const f32x4 ac = *(const f32x4*)(acs + 16 * kt + 4 * cq4);
                const bf16x8 khf = *(const bf16x8*)(cb_ + CKH + (16 * kt + cn) * VLD + cq4 * 8);
                cS[kt] = __builtin_amdgcn_mfma_f32_16x16x32_bf16(khf, ivf, cS[kt] * ac, 0, 0, 0);
            }
        }
        if (VAR != 4 && tile + 1 < 129) commit(buf ^ 1, preA, prevA);
        __syncthreads();
        if (VAR == 0 && MODE == 0 && half == 0 && t2 < 64 && (tile > 0 || ub == 0)) {
            const int tok = t2 >> 2, q4 = (t2 & 3) * 4, row = SCAN_ROW(tile, tok);
            if (half == 0) *(f32x4*)(YRAW + (size_t)row * 384 + bh * 64 + rg * 16 + q4) = *(const f32x4*)(sy + buf * 256 + tok * 16 + q4);
        }
    }
#undef SCAN_ROW
    __syncthreads();
}
__device__ __forceinline__ void scan_a(const Params& p, unsigned char* ldsb, int ua, int l) {
    const int tid = opaque_tid(), wid = tid >> 6, lane = tid & 63;
    const int b = ua / 6, ha = ua % 6, c0 = ha * 64;
    float* xs = (float*)ldsb;
    float* gs = xs + 67 * 64;
    float* us = gs + 64 * 64;
    float* gt = us + 64 * 64;
    float* seg = gt + 64 * 132;
    float* hc = seg + 8 * 64 * 2;
    bf16_t* ub = (bf16_t*)(hc + 128);
    bf16_t* wt = ub + 64 * 72;
    bf16_t* proj = (bf16_t*)(p.ws + WS_PROJ); bf16_t* ymeta = (bf16_t*)(p.ws + WS_YMETA);
    const int c = tid & 63, tg = tid >> 6;
    const float cw0 = p.a_conv_w[(l * 4 + 0) * 384 + c0 + c], cw1 = p.a_conv_w[(l * 4 + 1) * 384 + c0 + c], cw2 = p.a_conv_w[(l * 4 + 2) * 384 + c0 + c], cw3 = p.a_conv_w[(l * 4 + 3) * 384 + c0 + c];
    const float cbias = p.a_conv_b[l * 384 + c0 + c], br = p.a_b_r[l * 384 + c0 + c], bi = p.a_b_i[l * 384 + c0 + c];
    const float spl8 = 8.f * softplusf_(-p.a_lambda[l * 384 + c0 + c]);
    {
        const float* wr_ = p.a_w_r + ((size_t)(l * 6 + ha)) * 4096; const float* wi_ = p.a_w_i + ((size_t)(l * 6 + ha)) * 4096;
        for (int q = tid; q < 8192; q += NTHREADS) {
            const int g = q >> 12, k = (q >> 6) & 63, n = q & 63;
            wt[(g * 64 + n) * 72 + k] = f2bf(g ? wi_[k * 64 + n] : wr_[k * 64 + n]);
        }
        if (tid < 192) xs[tid] = 0.f;
        if (tid < 128) hc[tid] = 0.f;
    }
    __syncthreads();
    bf16x8 bfr[2];
    {
        const int n = lane & 15, quad = lane >> 4;
        bfr[0] = *(const bf16x8*)(wt + (wid * 16 + n) * 72 + quad * 8);
        bfr[1] = *(const bf16x8*)(wt + (wid * 16 + n) * 72 + 32 + quad * 8);
    }
    u32x4 px = {0u, 0u, 0u, 0u}, pg = {0u, 0u, 0u, 0u};
    const int ltok = tid >> 3, lc8 = (tid & 7) * 8;
#define A_ROW(tile, tok) ((tile) == 0 ? MROWS + (tok) : b * SEQ + ((tile) - 1) * 64 + (tok))
#define A_NTOK(tile) ((tile) == 0 ? 16 : 64)
    if (ltok < A_NTOK(0)) { const size_t ro = (size_t)A_ROW(0, ltok) * NIN; px = *(const u32x4*)(proj + ro + PC_XA + c0 + lc8); pg = *(const u32x4*)(proj + ro + PC_GA + c0 + lc8); }
    for (int tile = 0; tile < 33; ++tile) {
        const int ntok = A_NTOK(tile), cur = tile & 1;
        {
            float f[8]; unpack8(px, f);
            *(f32x4*)(xs + (3 + ltok) * 64 + lc8) = (f32x4){f[0], f[1], f[2], f[3]}; *(f32x4*)(xs + (3 + ltok) * 64 + lc8 + 4) = (f32x4){f[4], f[5], f[6], f[7]};
            unpack8(pg, f);
            *(f32x4*)(gs + ltok * 64 + lc8) = (f32x4){f[0], f[1], f[2], f[3]}; *(f32x4*)(gs + ltok * 64 + lc8 + 4) = (f32x4){f[4], f[5], f[6], f[7]};
        }
        __syncthreads();
        if (tile + 1 < 33 && ltok < A_NTOK(tile + 1)) { const size_t ro = (size_t)A_ROW(tile + 1, ltok) * NIN; px = *(const u32x4*)(proj + ro + PC_XA + c0 + lc8); pg = *(const u32x4*)(proj + ro + PC_GA + c0 + lc8); }
#pragma unroll
        for (int i = 0; i < 8; ++i) {
            const int tok = tg * 8 + i;
            const float u = cbias + cw0 * xs[tok * 64 + c] + cw1 * xs[(tok + 1) * 64 + c] + cw2 * xs[(tok + 2) * 64 + c] + cw3 * xs[(tok + 3) * 64 + c];
            us[tok * 64 + c] = u; ub[tok * 72 + c] = f2bf(u);
        }
        __syncthreads();
        {
            const int m = lane & 15, quad = lane >> 4;
#pragma unroll
            for (int mb = 0; mb < 4; ++mb) {
                const bf16x8 a0 = *(const bf16x8*)(ub + (mb * 16 + m) * 72 + quad * 8), a1 = *(const bf16x8*)(ub + (mb * 16 + m) * 72 + 32 + quad * 8);
                f32x4 acc = {0.f, 0.f, 0.f, 0.f};
                acc = __builtin_amdgcn_mfma_f32_16x16x32_bf16(a0, bfr[0], acc, 0, 0, 0);
                acc = __builtin_amdgcn_mfma_f32_16x16x32_bf16(a1, bfr[1], acc, 0, 0, 0);
#pragma unroll
                for (int j = 0; j < 4; ++j) gt[(mb * 16 + quad * 4 + j) * 132 + wid * 16 + m] = acc[j];
            }
        }
        __syncthreads();
        {
            float Ap = 1.f, hl = 0.f;
#pragma unroll
            for (int i = 0; i < 8; ++i) {
                const int tok = tg * 8 + i;
                float a = 1.f, dr = 0.f;
                if (tok < ntok) {
                    const float rr = sigmoidf_(gt[tok * 132 + c] + br), ii = sigmoidf_(gt[tok * 132 + 64 + c] + bi);
                    const float la = -rr * spl8;
                    a = __expf(la);
                    dr = sqrtf(fmaxf(1.f - a * a, 0.f)) * (ii * us[tok * 64 + c]);
                }
                hl = a * hl + dr; Ap *= a;
                gt[tok * 132 + c] = hl; gt[tok * 132 + 64 + c] = Ap;
            }
            seg[(tg * 64 + c) * 2] = Ap; seg[(tg * 64 + c) * 2 + 1] = hl;
        }
        float hist = 0.f;
        if (tid < 192) hist = xs[(ntok + (tid >> 6)) * 64 + c];
        __syncthreads();
        if (tid < 192) xs[(tid >> 6) * 64 + c] = hist;
        {
            float carry = hc[cur * 64 + c];
            for (int s = 0; s < tg; ++s) carry = seg[(s * 64 + c) * 2] * carry + seg[(s * 64 + c) * 2 + 1];
            float hlast = carry;
#pragma unroll
            for (int i = 0; i < 8; ++i) {
                const int tok = tg * 8 + i;
                const float h = gt[tok * 132 + c] + gt[tok * 132 + 64 + c] * carry;
                hlast = h;
                if (tok < ntok) {
                    const float y = h * geluf_(gs[tok * 64 + c]);
                    if (tile > 0) proj[(size_t)A_ROW(tile, tok) * NIN + PC_YA + c0 + c] = f2bf(y);
                    else if (b == 0) ymeta[tok * 1024 + c0 + c] = f2bf(y);
                }
            }
            if (tg == 7) hc[(cur ^ 1) * 64 + c] = hlast;
        }
        __syncthreads();
    }
#undef A_ROW
#undef A_NTOK
}
__device__ __forceinline__ void phase_post(const Params& p, int l) {
    const int tid = opaque_tid(), wid = tid >> 6, lane = tid & 63;
    const int gw = opaque_bid() * 8 + wid, nw = gridDim.x * 8;
    bf16_t* proj = (bf16_t*)(p.ws + WS_PROJ); const float* projf = (const float*)(p.ws + WS_PROJ);
    const float* YRAW = p.out;
    const bf16_t* PV = (const bf16_t*)(p.ws + WS_PV); const bf16_t* PG = (const bf16_t*)(p.ws + WS_PG);
    const float* BONUS = (const float*)(p.ws + WS_BONUS);
    bf16_t* ymeta = (bf16_t*)(p.ws + WS_YMETA);
    float yb[6], pv[6], pg[6], oc[4], og[4], bonl;
    auto load_row = [&](int row, float (&yb_)[6], float (&pv_)[6], float (&pg_)[6], float (&oc_)[4], float (&og_)[4], float& bonl_) __attribute__((always_inline)) {
#pragma unroll
        for (int h = 0; h < 6; ++h) { yb_[h] = YRAW[(size_t)row * 384 + h * 64 + lane]; pv_[h] = bf2f(PV[(size_t)row * 384 + h * 64 + lane]); pg_[h] = bf2f(PG[(size_t)row * 384 + h * 64 + lane]); }
#pragma unroll
        for (int h = 0; h < 4; ++h) { oc_[h] = projf[(size_t)row * 1536 + ORAW_F + h * 64 + lane]; og_[h] = bf2f(proj[(size_t)row * NIN + PC_OG + h * 64 + lane]); }
        bonl_ = lane < 6 ? BONUS[(size_t)row * 8 + lane] : 0.f;
    };
    const float cn = p.c_norm[l * 64 + lane];
    float lng[6], lnb[6];
#pragma unroll
    for (int h = 0; h < 6; ++h) { lng[h] = p.b_ln_g[l * 384 + h * 64 + lane]; lnb[h] = p.b_ln_b[l * 384 + h * 64 + lane]; }
    if (gw < RROWS) load_row(gw, yb, pv, pg, oc, og, bonl);
    for (int row = gw; row < RROWS; row += nw) {
        float yb2[6], pv2[6], pg2[6], oc2[4], og2[4], bonl2 = 0.f;
        const bool more = row + nw < RROWS;
        if (more) load_row(row + nw, yb2, pv2, pg2, oc2, og2, bonl2);
#pragma unroll
        for (int h = 0; h < 6; ++h) {
            const int cc = h * 64 + lane;
            const float mean = sum64(yb[h]) * (1.f / 64.f);
            const float dlt = yb[h] - mean;
            const float var = sum64(dlt * dlt) * (1.f / 64.f);
            float o = dlt * rsqrtf(var + 64e-5f) * lng[h] + lnb[h];
            const float bon = __builtin_bit_cast(float, __builtin_amdgcn_readlane(__builtin_bit_cast(int, bonl), h));
            o += bon * pv[h];
            o *= pg[h];
            if (row < MROWS) proj[(size_t)row * NIN + PC_YB + cc] = f2bf(o);
            else ymeta[(row - MROWS) * 1024 + 384 + cc] = f2bf(o);
        }
#pragma unroll
        for (int h = 0; h < 4; ++h) {
            const int cc = h * 64 + lane;
            const float ms = sum64(oc[h] * oc[h]) * (1.f / 64.f);
            const float r = oc[h] * rsqrtf(ms + 1e-6f) * cn * siluf_(og[h]);
            if (row < MROWS) proj[(size_t)row * NIN + PC_YC + cc] = f2bf(r);
            else ymeta[(row - MROWS) * 1024 + 768 + cc] = f2bf(r);
        }
        if (more) {
#pragma unroll
            for (int h = 0; h < 6; ++h) { yb[h] = yb2[h]; pv[h] = pv2[h]; pg[h] = pg2[h]; }
#pragma unroll
            for (int h = 0; h < 4; ++h) { oc[h] = oc2[h]; og[h] = og2[h]; }
            bonl = bonl2;
        }
    }
}

#ifndef PHMASK
#define PHMASK 0x1ff
#endif
#define PHM(k) (((PHMASK) >> (k)) & 1)
#ifndef SCAN_VAR
#define SCAN_VAR 0
#endif
#ifndef PROBE_ID
#define PROBE_ID 0
#endif
#define PROBE_MULT 4
#define PRB(id, ...) do { unsigned long long _t0 = 0; if (PROBE_ID == (id)) _t0 = __builtin_amdgcn_s_memrealtime(); __VA_ARGS__; if (PROBE_ID == (id)) prb_acc += __builtin_amdgcn_s_memrealtime() - _t0; } while (0)
__global__ void __launch_bounds__(NTHREADS, 2) hymba_fwd(Params pin) {
#if defined(__HIP_DEVICE_COMPILE__)
    extern __shared__ __attribute__((aligned(16))) unsigned char shm[];
    cg::grid_group grid = cg::this_grid();
    float* ldsf = (float*)shm;
    pg8::StaticOrder S;
    unsigned long long prb_acc = 0;
    volatile LAS unsigned* xst = (volatile LAS unsigned*)(shm + LDS_BYTES);
    if (threadIdx.x == 0) { xst[0] = 0u; xst[1] = 0u; }
    if (blockIdx.x == 0) { unsigned* bw = (unsigned*)(pin.ws + WS_BAR); for (int i = threadIdx.x; i < XCD_BAR_WORDS; i += NTHREADS) bw[i] = 0u; }
    XcdBarrier xb; xb.bar = (unsigned*)(pin.ws + WS_BAR); xb.x = 0; xb.st = xst;
    typedef const __attribute__((address_space(4))) Params* KP;
    for (int ph = pin.ph_lo; ph < pin.ph_hi; ++ph) {
        KP kp = (KP)__builtin_amdgcn_kernarg_segment_ptr(); asm volatile("" : "+s"(kp));
        const Params p = *kp;
        unsigned char* ws = p.ws;
        bf16_t* WIN = (bf16_t*)(ws + WS_WIN); bf16_t* WOUT = (bf16_t*)(ws + WS_WOUT); bf16_t* WUP = (bf16_t*)(ws + WS_WUP); bf16_t* WDN = (bf16_t*)(ws + WS_WDN);
        const bool conv_in_scan = gridDim.x > 240;
        bf16_t* HB = (bf16_t*)(ws + WS_HB); bf16_t* PROJ = (bf16_t*)(ws + WS_PROJ); bf16_t* U = PROJ;
        unsigned long long* SSQ = (unsigned long long*)(ws + WS_SSQ); float* HMETA = (float*)(ws + WS_HMETA); bf16_t* YMETA = (bf16_t*)(ws + WS_YMETA);
        if (PHM(0) && ph == 0) {
            PRB(1, phase_p0(p));
            PRB(2, conv_w(ldsf, p.w_in, 1024, NIN, WIN, p.mix_norm, opaque_bid(), (int)gridDim.x));
        } else if (PHM(8) && ph == 29) {
            PRB(3, phase_final(p));
        } else {
            const int l = (ph - 1) / 7, sub = (ph - 1) % 7;
            if (PHM(1) && sub == 0) {
                EpScale<0> E{PROJ, NIN, SSQ + (size_t)(2 * l) * RROWS};
                PRB(4, meta_gemm(ldsf, HB + (size_t)MROWS * 1024, 1024, WIN, NIN, 1024, E));
                pg8::Gemm g{HB, WIN, MROWS, NIN, 1024, 1024};
                S.init(MROWS, NIN, (int)gridDim.x, (int)opaque_bid());
                PRB(5, pg8::gemm_phase<EpScale<0>, pg8::StaticOrder, false>((PG8_LAS unsigned char*)shm, g, S, E));
            } else if (PHM(2) && sub == 1) {
                if (!conv_in_scan) {
                    conv_w(ldsf, p.w_out + (size_t)l * 1024 * 1024, 1024, 1024, WOUT, nullptr, opaque_bid(), (int)gridDim.x);
                    conv_w(ldsf, p.w_up + (size_t)l * 1024 * DFF, 1024, DFF, WUP, p.ffn_norm + l * 1024, opaque_bid(), (int)gridDim.x);
                    conv_w(ldsf, p.w_down + (size_t)l * DFF * 1024, DFF, 1024, WDN, nullptr, opaque_bid(), (int)gridDim.x);
                    if (l + 1 < DEPTH) conv_w(ldsf, p.w_in + (size_t)(l + 1) * 1024 * NIN, 1024, NIN, WIN, p.mix_norm + (l + 1) * 1024, opaque_bid(), (int)gridDim.x);
                    __syncthreads();
                }
                PRB(6, phase_prep(p, shm, l));
            } else if (PHM(3) && sub == 2) {
                for (int s = opaque_bid(); s < 256; s += gridDim.x) {
                    if (s < 192) PRB(7, scan_bc<0, 0>(p, ldsf, s, l)); else if (s < 240) PRB(8, scan_a(p, shm, s - 192, l)); else PRB(14, scan_bc<0, 1>(p, ldsf, s - 240, l));
                    __syncthreads();
                }
                if (conv_in_scan && opaque_bid() >= 240) {
                    const int cw = opaque_bid() - 240, ncw = (int)gridDim.x - 240;
                    PRB(2, conv_w(ldsf, p.w_out + (size_t)l * 1024 * 1024, 1024, 1024, WOUT, nullptr, cw, ncw));
                    PRB(2, conv_w(ldsf, p.w_up + (size_t)l * 1024 * DFF, 1024, DFF, WUP, p.ffn_norm + l * 1024, cw, ncw));
                } else if (conv_in_scan && opaque_bid() >= 192) {
                    const int cw = opaque_bid() - 192, ncw = 48;
                    PRB(2, conv_w(ldsf, p.w_down + (size_t)l * DFF * 1024, DFF, 1024, WDN, nullptr, cw, ncw));
                    if (l + 1 < DEPTH) PRB(2, conv_w(ldsf, p.w_in + (size_t)(l + 1) * 1024 * NIN, 1024, NIN, WIN, p.mix_norm + (l + 1) * 1024, cw, ncw));
                }
            } else if (PHM(4) && sub == 3) {
                PRB(9, phase_post(p, l));
            } else if (PHM(5) && sub == 4) {
                EpRes E{HMETA, HB, SSQ + (size_t)(2 * l + 1) * RROWS};
                PRB(4, meta_gemm(ldsf, YMETA, 1024, WOUT, 1024, 1024, E));
                pg8::Gemm g{PROJ, WOUT, MROWS, 1024, 1024, NIN};
                S.init(MROWS, 1024, (int)gridDim.x, (int)opaque_bid());
                PRB(10, pg8::gemm_phase<EpRes, pg8::StaticOrder, false>((PG8_LAS unsigned char*)shm, g, S, E));
            } else if (PHM(6) && sub == 5) {
                EpScale<1> E{U, DFF, SSQ + (size_t)(2 * l + 1) * RROWS};
                PRB(4, meta_gemm(ldsf, HB + (size_t)MROWS * 1024, 1024, WUP, DFF, 1024, E));
                pg8::Gemm g{HB, WUP, MROWS, DFF, 1024, 1024};
                S.init(MROWS, DFF, (int)gridDim.x, (int)opaque_bid());
                PRB(11, pg8::gemm_phase<EpScale<1>, pg8::StaticOrder, false>((PG8_LAS unsigned char*)shm, g, S, E));
            } else if (PHM(7)) {
                EpRes E{HMETA, HB, SSQ + (size_t)(2 * l + 2) * RROWS};
                PRB(4, meta_gemm(ldsf, U + (size_t)MROWS * DFF, DFF, WDN, 1024, DFF, E));
                pg8::Gemm g{U, WDN, MROWS, 1024, DFF, DFF};
                S.init(MROWS, 1024, (int)gridDim.x, (int)opaque_bid());
                PRB(12, pg8::gemm_phase<EpRes, pg8::StaticOrder, false>((PG8_LAS unsigned char*)shm, g, S, E));
            }
        }
        if (ph + 1 < pin.ph_hi) { if (ph == pin.ph_lo) { PRB(13, grid.sync()); xb = xcd_barrier_post((unsigned*)(pin.ws + WS_BAR), xst); } else PRB(13, xcd_barrier(xb)); }
    }
    if (PROBE_ID != 0) { const unsigned long long t0 = __builtin_amdgcn_s_memrealtime(); while (__builtin_amdgcn_s_memrealtime() - t0 < PROBE_MULT * prb_acc) __builtin_amdgcn_s_sleep(8); }
#endif
}

extern "C" void kernel_launch(void* const* d_in, const int* in_sizes, int n_in, void* d_out, int out_size, void* d_ws, size_t ws_size, hipStream_t stream) {
    static int grid_blocks = 0;
    if (grid_blocks == 0) {
        if (n_in != 32 || ws_size < WS_END) { fprintf(stderr, "kernel_launch: unexpected n_in %d / ws_size %zu (need %zu)\n", n_in, ws_size, (size_t)WS_END); grid_blocks = -1; return; }
        int dev = 0, cus = 0, per_cu = 0;
        hipGetDevice(&dev);
        hipDeviceGetAttribute(&cus, hipDeviceAttributeMultiprocessorCount, dev);
        if (hipFuncSetAttribute((const void*)hymba_fwd, hipFuncAttributeMaxDynamicSharedMemorySize, LDS_ALLOC) != hipSuccess) { fprintf(stderr, "hipFuncSetAttribute failed\n"); grid_blocks = -1; return; }
        if (hipOccupancyMaxActiveBlocksPerMultiprocessor(&per_cu, (const void*)hymba_fwd, NTHREADS, LDS_ALLOC) != hipSuccess || per_cu < 1) { fprintf(stderr, "occupancy query failed (%d)\n", per_cu); (void)hipGetLastError(); per_cu = 1; }
        grid_blocks = cus * (per_cu > 1 ? 1 : per_cu);
        fprintf(stderr, "kernel_launch: %d CUs, %d blocks/CU by query, grid %d\n", cus, per_cu, grid_blocks);
    }
    if (grid_blocks < 0) return;
    Params p{};
    const float** pp = (const float**)&p;
    for (int i = 0; i < 32; ++i) pp[i] = (const float*)d_in[i];
    p.out = (float*)d_out; p.ws = (unsigned char*)d_ws;
#ifndef MK_PER_PHASE
    p.ph_lo = 0; p.ph_hi = 30;
    void* args[] = {&p};
    hipError_t e = hipLaunchCooperativeKernel((const void*)hymba_fwd, dim3(grid_blocks), dim3(NTHREADS), args, LDS_ALLOC, stream);
    if (e != hipSuccess) fprintf(stderr, "cooperative launch failed: %s (grid %d)\n", hipGetErrorString(e), grid_blocks);
#else
    for (int ph = 0; ph < 30; ++ph) {
        p.ph_lo = ph; p.ph_hi = ph + 1;
        hipLaunchKernelGGL(hymba_fwd, dim3(grid_blocks), dim3(NTHREADS), LDS_ALLOC, stream, p);
    }
#endif
}
```

```cpp
#include <hip/hip_runtime.h>
#include <hip/hip_cooperative_groups.h>
#include <cstdio>
namespace cg = cooperative_groups;

#define LAS __attribute__((address_space(3)))
typedef unsigned short bf16_t;
typedef short bf16x8 __attribute__((ext_vector_type(8)));
typedef float f32x4 __attribute__((ext_vector_type(4)));
typedef float f32x2 __attribute__((ext_vector_type(2)));
typedef unsigned u32x4 __attribute__((ext_vector_type(4)));
typedef unsigned u32x2 __attribute__((ext_vector_type(2)));

constexpr int D = 1024, NBATCH = 8, SEQ = 2048, NMETA = 16, LTOK = SEQ + NMETA, MROWS = NBATCH * SEQ, RROWS = MROWS + NMETA, DEPTH = 4;
constexpr int NIN = 3072, DFF = 4096, BCOLS = 1280;
constexpr int LDS_BYTES = 131072, LDS_ALLOC = LDS_BYTES + 16, NTHREADS = 512;
constexpr int PC_XA = 0, PC_GA = 384, PC_B = 768, PC_Q = 2048, PC_FZ = 2304, PC_I = 2560, PC_OG = 2816;
constexpr int PC_YA = 0, PC_YB = 384, PC_YC = 768;
constexpr size_t ACB_F = 8388608;
constexpr size_t WTL_F = 9437184;
constexpr int ORAW_F = 576;

constexpr size_t WS_WIN = 0, WS_WOUT = 6291456, WS_WUP = 8388608, WS_WDN = 16777216;
constexpr size_t WS_HB = 25165824;
constexpr size_t WS_PROJ = WS_HB + (size_t)RROWS * 1024 * 2;
constexpr size_t WS_PS = WS_PROJ + (size_t)RROWS * 3072 * 2;
constexpr size_t WS_PV = WS_PS + (size_t)RROWS * 6 * 320 * 2;
constexpr size_t WS_PG = WS_PV + (size_t)RROWS * 384 * 2;
constexpr size_t WS_VF = WS_PG + (size_t)RROWS * 384 * 2;
constexpr size_t WS_BONUS = WS_VF + (size_t)RROWS * 384 * 2;
constexpr size_t WS_SSQ = WS_BONUS + (size_t)RROWS * 8 * 4;
constexpr size_t WS_HMETA = WS_SSQ + (size_t)9 * RROWS * 8;
constexpr size_t WS_YMETA = WS_HMETA + (size_t)16 * 1024 * 4;
constexpr size_t WS_BAR = WS_YMETA + (size_t)16 * 1024 * 2;
constexpr size_t WS_END = WS_BAR + 16384;
static_assert((size_t)RROWS * 4096 * 2 <= WS_VF - WS_PROJ, "U must fit in PROJ..PG");
static_assert((size_t)RROWS * 384 * 4 <= (size_t)RROWS * 1024 * 2, "YRAW must fit in HB");
static_assert(WS_END <= 268435456ull, "workspace");

struct Params {
    const float *x, *meta, *mix_norm, *w_in, *a_conv_w, *a_conv_b, *a_w_r, *a_b_r, *a_w_i, *a_b_i, *a_lambda;
    const float *b_mu, *b_w0, *b_w2, *b_a0, *b_a2, *b_g2, *b_k_k, *b_k_a, *b_r_k, *b_ln_g, *b_ln_b, *b_v0, *b_v1, *b_v2;
    const float *c_lb, *c_norm, *w_out, *ffn_norm, *w_up, *w_down, *final_norm;
    float* out; unsigned char* ws;
    int ph_lo, ph_hi;
};

__device__ __forceinline__ int opaque_bid() { int t = blockIdx.x; asm volatile("" : "+s"(t)); return t; }
__device__ __forceinline__ int opaque_tid() { int t = threadIdx.x; asm volatile("" : "+v"(t)); return t; }
__device__ __forceinline__ unsigned cvt_pk_bf16(float lo, float hi) { unsigned r; asm volatile("v_cvt_pk_bf16_f32 %0, %1, %2" : "=v"(r) : "v"(lo), "v"(hi)); return r; }
__device__ __forceinline__ bf16_t f2bf(float f) { return (bf16_t)(cvt_pk_bf16(f, 0.f) & 0xffffu); }
__device__ __forceinline__ float bf2f(unsigned short b) { return __uint_as_float(((unsigned)b) << 16); }
__device__ __forceinline__ float bflo(unsigned u) { return __uint_as_float(u << 16); }
__device__ __forceinline__ float bfhi(unsigned u) { return __uint_as_float(u & 0xffff0000u); }
__device__ __forceinline__ float rcpf_(float x) { return __builtin_amdgcn_rcpf(x); }
__device__ __forceinline__ float sigmoidf_(float x) { return rcpf_(1.f + __expf(-x)); }
__device__ __forceinline__ float siluf_(float x) { return x * sigmoidf_(x); }
__device__ __forceinline__ float softplusf_(float x) { return fmaxf(x, 0.f) + log1pf(__expf(-fabsf(x))); }
__device__ __forceinline__ float tanhf_(float x) { const float e = __expf(-2.f * fabsf(x)); const float t = (1.f - e) * rcpf_(1.f + e); return x < 0.f ? -t : t; }
__device__ __forceinline__ float geluf_(float x) { return 0.5f * x * (1.f + tanhf_(0.7978845608028654f * (x + 0.044715f * x * x * x))); }

template <int CTRL> __device__ __forceinline__ float dppf(float x) { return __builtin_bit_cast(float, __builtin_amdgcn_update_dpp(0, __builtin_bit_cast(int, x), CTRL, 0xF, 0xF, true)); }
template <int CTRL> __device__ __forceinline__ float dppf1(float x) { return __builtin_bit_cast(float, __builtin_amdgcn_update_dpp(0x3f800000, __builtin_bit_cast(int, x), CTRL, 0xF, 0xF, false)); }
__device__ __forceinline__ float sum16(float x) {
    x += dppf<0xB1>(x); x += dppf<0x4E>(x); x += dppf<0x141>(x); x += dppf<0x140>(x); return x;
}
__device__ __forceinline__ float sum64(float x) {
    x = sum16(x);
    const int xi = __builtin_bit_cast(int, x);
    const float a = __builtin_bit_cast(float, __builtin_amdgcn_readlane(xi, 0)), b = __builtin_bit_cast(float, __builtin_amdgcn_readlane(xi, 16));
    const float c = __builtin_bit_cast(float, __builtin_amdgcn_readlane(xi, 32)), d = __builtin_bit_cast(float, __builtin_amdgcn_readlane(xi, 48));
    return (a + b) + (c + d);
}
__device__ __forceinline__ void unpack8(const u32x4 v, float* f) {
    f[0] = bflo(v.x); f[1] = bfhi(v.x); f[2] = bflo(v.y); f[3] = bfhi(v.y); f[4] = bflo(v.z); f[5] = bfhi(v.z); f[6] = bflo(v.w); f[7] = bfhi(v.w);
}
namespace pg8 {
#define PG8_LAS __attribute__((address_space(3)))
constexpr int BM = 256, BK = 64, HALF = 128, HTB = HALF * BK * 2  , STAGE_BYTES = 8 * HTB, NXCD = 8, WGM = 8;

__host__ __device__ __forceinline__ int lds_byte(int r, int c) { const int st = (r >> 4) * 2 + (c >> 5), rr = r & 15, cc = c & 31, ob = rr * 64 + cc * 2; return st * 1024 + (ob ^ (((ob >> 9) & 1) << 5)); }
__host__ __device__ __forceinline__ void stage_rc(int b, int& R, int& C) { const int st = b / 1024, sb = b % 1024, swz = sb ^ (((sb >> 9) & 1) << 5); R = (st >> 1) * 16 + swz / 64; C = (st & 1) * 32 + (swz % 64) / 2; }
__host__ __device__ __forceinline__ int perm32(int rho) { const int n = rho >> 4, i = rho & 15; return 8 * (i >> 2) + 4 * n + (i & 3); }

struct Unit { int pm, pn; };
struct Gemm { const bf16_t* A; const bf16_t* Bt; int M, N, K, lda; };

struct StaticOrder {
    int nM, nN, nwg, G, c;
    __host__ __device__ void init(int M, int N, int G_, int c_) { nM = M / BM; nN = N / BM; nwg = nM * nN; G = G_; c = c_; }
    __host__ __device__ bool next(int i, Unit& u) const {
        const long L = (long)i * G + c; if (L >= nwg) return false;
        int wgid = (int)L; { const int q = nwg / NXCD, r = nwg % NXCD, xcd = wgid % NXCD, off = wgid / NXCD; wgid = (xcd < r ? xcd * (q + 1) : r * (q + 1) + (xcd - r) * q) + off; }
        const int nig = WGM * nN, gid = wgid / nig, fm = gid * WGM, gsz = (nM - fm) < WGM ? (nM - fm) : WGM;
        u.pm = fm + ((wgid % nig) % gsz); u.pn = (wgid % nig) / gsz; return true;
    }
    __device__ __forceinline__ void a_ready(const Unit&) const {}
    __device__ __forceinline__ void done(const Unit&) const {}
};


template <class Epi, class Sched, bool AMAP>
__device__ __forceinline__ void gemm_phase(PG8_LAS unsigned char* lds, const Gemm g, const Sched& S, const Epi& E) {
    const int tid = opaque_tid(), wid = __builtin_amdgcn_readfirstlane(tid >> 6), lane = tid & 63, wr = wid >> 2, wc = wid & 3, fr = lane & 15, fq = lane >> 4;
    const int K = g.K, nt = K / BK;
    unsigned voffA[2], voffB[2];
#pragma unroll
    for (int i = 0; i < 2; ++i) { int R, C; stage_rc(tid * 16 + i * 8192, R, C); const int Rb = Epi::PERM ? ((R & ~31) + perm32(R & 31)) : R;
        voffA[i] = (unsigned)(R * g.lda + C) * 2u; voffB[i] = (unsigned)(Rb * K + C) * 2u; }
    const size_t kstep = (size_t)(BK * 2);
    const size_t hstep = (size_t)HALF * K * 2;
    const size_t tstep = 2 * hstep;
    const size_t hstepA = (size_t)HALF * g.lda * 2, tstepA = 2 * hstepA;
#define PG8_KOFS(t) ((size_t)(AMAP ? ((t) * 64 + ((t) >= 12 ? 1280 : ((t) >= 6 ? 384 : 0))) : (t) * 64) * 2)
    const unsigned ldsw = (unsigned)wid * 1024u;
    const int aoff = lds_byte(wr * 64 + fr, fq * 8), boff = lds_byte(wc * 32 + fr, fq * 8);
#define PG8_SA(b, h) (((b) * 2 + (h)) * HTB)
#define PG8_SB(b, h) ((4 + (b) * 2 + (h)) * HTB)
#define PG8_STAGE(bufoff, gbase, voff) do { _Pragma("unroll") for (int _i = 0; _i < 2; ++_i) \
        __builtin_amdgcn_global_load_lds((const unsigned*)((const char*)(gbase) + (voff)[_i]), (PG8_LAS unsigned*)(lds + (bufoff) + ldsw + _i * 8192), 16, 0, 0); } while (0)
#define PG8_LDA(dst, b, h) do { _Pragma("unroll") for (int m = 0; m < 4; ++m) _Pragma("unroll") for (int k = 0; k < 2; ++k) dst[m][k] = *(const PG8_LAS bf16x8*)(lds + PG8_SA(b, h) + aoff + m * 2048 + k * 1024); } while (0)
#define PG8_LDB(dst, b, h) do { _Pragma("unroll") for (int n = 0; n < 2; ++n) _Pragma("unroll") for (int k = 0; k < 2; ++k) dst[n][k] = *(const PG8_LAS bf16x8*)(lds + PG8_SB(b, h) + boff + n * 2048 + k * 1024); } while (0)
#define PG8_MMA(ai, bj, At, Bt) do { __builtin_amdgcn_s_setprio(1); _Pragma("unroll") for (int m = 0; m < 4; ++m) _Pragma("unroll") for (int n = 0; n < 2; ++n) _Pragma("unroll") for (int k = 0; k < 2; ++k) \
        acc[ai][bj][m][n] = __builtin_amdgcn_mfma_f32_16x16x32_bf16(Bt[n][k], At[m][k], acc[ai][bj][m][n], 0, 0, 0); __builtin_amdgcn_s_setprio(0); } while (0)
#define PG8_WAIT_V(n) asm volatile("s_waitcnt vmcnt(" #n ")" ::: "memory")
#define PG8_WAIT_L(n) asm volatile("s_waitcnt lgkmcnt(" #n ")" ::: "memory")
#define PG8_BAR __builtin_amdgcn_s_barrier()
#define PG8_SCHED __builtin_amdgcn_sched_barrier(0)
    Unit cur, nxt; int ui = 0;
    if (!S.next(0, cur)) return;
    f32x4 acc[2][2][4][2];
#pragma unroll
    for (int a = 0; a < 2; ++a)
#pragma unroll
        for (int b = 0; b < 2; ++b)
#pragma unroll
            for (int m = 0; m < 4; ++m)
#pragma unroll
                for (int n = 0; n < 2; ++n) acc[a][b][m][n] = (f32x4){0.f, 0.f, 0.f, 0.f};
    bf16x8 At[4][2], B0[2][2], B1[2][2];
    const char* cA = (const char*)g.A + (size_t)cur.pm * tstepA; const char* cB = (const char*)g.Bt + (size_t)cur.pn * tstep;
    S.a_ready(cur);
    PG8_STAGE(PG8_SB(0, 0), cB, voffB); PG8_STAGE(PG8_SA(0, 0), cA, voffA); PG8_STAGE(PG8_SB(0, 1), cB + hstep, voffB); PG8_STAGE(PG8_SA(0, 1), cA + hstepA, voffA);
    if (wr == 1) PG8_BAR;
    PG8_WAIT_V(4); PG8_BAR;
    PG8_STAGE(PG8_SB(1, 0), cB + kstep, voffB); PG8_STAGE(PG8_SA(1, 0), cA + PG8_KOFS(1), voffA); PG8_STAGE(PG8_SB(1, 1), cB + hstep + kstep, voffB);
    PG8_WAIT_V(6); PG8_BAR;
    for (;;) {
        const bool has_next = S.next(ui + 1, nxt);
        const char* nA = has_next ? (const char*)g.A + (size_t)nxt.pm * tstepA : cA; const char* nB = has_next ? (const char*)g.Bt + (size_t)nxt.pn * tstep : cB;
        for (int t = 0; t < nt; t += 2) {
            const bool last = (t == nt - 2);
            const char* a1 = cA + PG8_KOFS(t + 1);
            const char* a2 = last ? nA : cA + PG8_KOFS(t + 2); const char* b2 = last ? nB : cB + (size_t)(t + 2) * kstep;
            const char* a3 = last ? nA + PG8_KOFS(1) : cA + PG8_KOFS(t + 3); const char* b3 = b2 + kstep;
            if (last && has_next) S.a_ready(nxt);
            PG8_LDB(B0, 0, 0); PG8_SCHED; PG8_LDA(At, 0, 0); PG8_STAGE(PG8_SA(1, 1), a1 + hstepA, voffA);
            PG8_WAIT_L(8); PG8_BAR; PG8_WAIT_L(0); PG8_MMA(0, 0, At, B0); PG8_BAR; PG8_SCHED;
            PG8_LDB(B1, 0, 1); PG8_STAGE(PG8_SB(0, 0), b2, voffB);
            PG8_BAR; PG8_WAIT_L(0); PG8_MMA(0, 1, At, B1); PG8_BAR;
            PG8_LDA(At, 0, 1); PG8_STAGE(PG8_SA(0, 0), a2, voffA);
            PG8_BAR; PG8_WAIT_L(0); PG8_MMA(1, 0, At, B0); PG8_BAR; PG8_SCHED;
            PG8_STAGE(PG8_SB(0, 1), b2 + hstep, voffB);
            PG8_WAIT_V(6); PG8_BAR; PG8_MMA(1, 1, At, B1); PG8_BAR;
            PG8_LDB(B0, 1, 0); PG8_SCHED; PG8_LDA(At, 1, 0); PG8_STAGE(PG8_SA(0, 1), a2 + hstepA, voffA);
            PG8_WAIT_L(8); PG8_BAR; PG8_WAIT_L(0); PG8_MMA(0, 0, At, B0); PG8_BAR; PG8_SCHED;
            PG8_LDB(B1, 1, 1); PG8_STAGE(PG8_SB(1, 0), b3, voffB);
            PG8_BAR; PG8_WAIT_L(0); PG8_MMA(0, 1, At, B1); PG8_BAR;
            PG8_LDA(At, 1, 1); PG8_STAGE(PG8_SA(1, 0), a3, voffA);
            PG8_BAR; PG8_WAIT_L(0); PG8_MMA(1, 0, At, B0); PG8_BAR; PG8_SCHED;
            PG8_STAGE(PG8_SB(1, 1), b3 + hstep, voffB);
            PG8_WAIT_V(6); PG8_BAR; PG8_MMA(1, 1, At, B1); PG8_BAR;
        }
        if constexpr (!Epi::AFTER_DRAIN) { E(acc, cur, wr, wc, fr, fq); S.done(cur); }
        if (!has_next) break;
#pragma unroll
        for (int a = 0; a < 2; ++a)
#pragma unroll
            for (int b = 0; b < 2; ++b)
#pragma unroll
                for (int m = 0; m < 4; ++m)
#pragma unroll
                    for (int n = 0; n < 2; ++n) acc[a][b][m][n] = (f32x4){0.f, 0.f, 0.f, 0.f};
        cur = nxt; cA = nA; cB = nB; ++ui;
    }
    PG8_WAIT_V(0);
    if (wr == 0) PG8_BAR;
    PG8_BAR;
    if constexpr (Epi::AFTER_DRAIN) { E.fused(acc, cur, wr, wc, fr, fq, lds, wid, lane); S.done(cur); }
#undef PG8_SA
#undef PG8_KOFS
#undef PG8_SB
#undef PG8_STAGE
#undef PG8_LDA
#undef PG8_LDB
#undef PG8_MMA
#undef PG8_WAIT_V
#undef PG8_WAIT_L
#undef PG8_BAR
#undef PG8_SCHED
}
}


#define XB_TMO      128
#define XB_XCNT(j)  (256  + 64 * (j))
#define XB_XSUB(j)  (1280 + 64 * (j))
#define XB_XGEN(j)  (2304 + 64 * (j))
#define XB_TOP      3328
#define XB_TOPGEN   3392
#define XCD_BAR_WORDS 3456
#define XB_SPIN_CAP (1u << 18)

__device__ __forceinline__ unsigned xb_ld(unsigned* p)              { return __hip_atomic_load(p, __ATOMIC_RELAXED, __HIP_MEMORY_SCOPE_AGENT); }

__device__ __forceinline__ unsigned xb_add(unsigned* p, unsigned v) { return __hip_atomic_fetch_add(p, v, __ATOMIC_RELAXED, __HIP_MEMORY_SCOPE_AGENT); }
__device__ __forceinline__ unsigned xb_xcc_id() { return (unsigned)__builtin_amdgcn_s_getreg((3 << 11) | 20) & 0xFu; }
#define XB_SPIN(cond, bar) do { unsigned _sp = 0; while (cond) { __builtin_amdgcn_s_sleep(1); \
    if ((++_sp & 255u) == 0u) { if (xb_ld(&(bar)[XB_TMO])) break; if (_sp > XB_SPIN_CAP) { atomicAdd(&(bar)[XB_TMO], 1u); break; } } } } while (0)

struct XcdBarrier {
    unsigned* bar; unsigned x;
    volatile LAS unsigned* st;
};

__device__ __forceinline__ XcdBarrier xcd_barrier_post(unsigned* bar, volatile LAS unsigned* st) {
    XcdBarrier b; b.bar = bar; b.x = xb_xcc_id(); b.st = st;
    if (threadIdx.x == 0) (void)xb_add(&bar[XB_XCNT(b.x)], 1u);
    return b;
}
__device__ __forceinline__ void xcd_barrier_complete(unsigned* bar, unsigned x, unsigned& nloc, unsigned& nx) {
    const unsigned G = gridDim.x * gridDim.y * gridDim.z;
    unsigned sum, cnt, mine, sp = 0u;
    for (;;) {
        sum = 0u; cnt = 0u; mine = 0u;
#pragma unroll
        for (unsigned j = 0; j < 16; ++j) { const unsigned c = xb_ld(&bar[XB_XCNT(j)]); sum += c; cnt += (c > 0u) ? 1u : 0u; mine = (j == x) ? c : mine; }
        if (sum == G) break;
        __builtin_amdgcn_s_sleep(1);
        if ((++sp & 255u) == 0u) { if (xb_ld(&bar[XB_TMO])) break; if (sp > XB_SPIN_CAP) { atomicAdd(&bar[XB_TMO], 1u); break; } }
    }
    nloc = mine > 0u ? mine : 1u; nx = cnt > 0u ? cnt : 1u;
}

__device__ __forceinline__ void xcd_barrier(const XcdBarrier& b) {
    asm volatile("s_waitcnt vmcnt(0)" ::: "memory");
    __syncthreads();
    if (threadIdx.x == 0) {
        unsigned* bar = b.bar;
        __builtin_amdgcn_s_waitcnt(0);
        unsigned nloc = b.st[0], nx = b.st[1];
        if (nloc == 0u) { xcd_barrier_complete(bar, b.x, nloc, nx); b.st[0] = nloc; b.st[1] = nx; }
        const unsigned old = xb_add(&bar[XB_XSUB(b.x)], 1u);
        const unsigned gen = old / nloc;
        if (old + 1u == (gen + 1u) * nloc) {
            __builtin_amdgcn_fence(__ATOMIC_RELEASE, "agent");
            asm volatile("s_waitcnt vmcnt(0)" ::: "memory");
            const unsigned og = xb_add(&bar[XB_TOP], 1u);
            const unsigned tg = og / nx;
            if (og + 1u == (tg + 1u) * nx) xb_add(&bar[XB_TOPGEN], 1u);
            else XB_SPIN(xb_ld(&bar[XB_TOPGEN]) == tg, bar);
            __builtin_amdgcn_fence(__ATOMIC_ACQUIRE, "agent");
            xb_add(&bar[XB_XGEN(b.x)], 1u);
            asm volatile("s_waitcnt vmcnt(0)" ::: "memory");
        } else {
            XB_SPIN(xb_ld(&bar[XB_XGEN(b.x)]) == gen, bar);
            __builtin_amdgcn_fence(__ATOMIC_ACQUIRE, "agent");
            asm volatile("s_waitcnt vmcnt(0)" ::: "memory");
        }
    }
    __syncthreads();
}
constexpr float SSQ_SCALE = 16777216.f, SSQ_INV = 1.f / (16777216.f * 1024.f);
template <int ACT  > struct EpScale {
    static constexpr bool PERM = true, AFTER_DRAIN = false;
    bf16_t* O; int ldo; const unsigned long long* ssq;
    __device__ __forceinline__ u32x2 pack(f32x4 v, float rs) const {
        v = v * rs;
        if (ACT == 1) { v.x = fmaxf(v.x, 0.f); v.y = fmaxf(v.y, 0.f); v.z = fmaxf(v.z, 0.f); v.w = fmaxf(v.w, 0.f); v = v * v; }
        u32x2 o; o.x = cvt_pk_bf16(v.x, v.y); o.y = cvt_pk_bf16(v.z, v.w); return o;
    }
    __device__ __forceinline__ void operator()(const f32x4 (&acc)[2][2][4][2], const pg8::Unit& u, int wr, int wc, int fr, int fq) const {
        const int row0 = u.pm * 256 + wr * 64 + fr, col0 = u.pn * 256 + wc * 32 + 8 * fq;
        unsigned long long sq[2][4];
#pragma unroll
        for (int ai = 0; ai < 2; ++ai)
#pragma unroll
            for (int m = 0; m < 4; ++m) sq[ai][m] = ssq[row0 + ai * 128 + m * 16];
#pragma unroll
        for (int ai = 0; ai < 2; ++ai)
#pragma unroll
            for (int m = 0; m < 4; ++m) {
                const int row = row0 + ai * 128 + m * 16;
                const float rs = rsqrtf((float)sq[ai][m] * SSQ_INV + 1e-6f);
                bf16_t* rp = O + (size_t)row * ldo + col0;
#pragma unroll
                for (int bj = 0; bj < 2; ++bj) {
                    const u32x2 lo = pack(acc[ai][bj][m][0], rs), hi = pack(acc[ai][bj][m][1], rs);
                    u32x4 o; o.x = lo.x; o.y = lo.y; o.z = hi.x; o.w = hi.y;
                    *(u32x4*)(rp + bj * 128) = o;
                }
                asm volatile("" ::: "memory");
            }
    }
    __device__ __forceinline__ void meta(int m, int col, f32x4 v) const {
        const int row = MROWS + m;
        const float rs = rsqrtf((float)ssq[row] * SSQ_INV + 1e-6f);
        *(u32x2*)(O + (size_t)row * ldo + col) = pack(v, rs);
    }
};
struct EpRes {
    static constexpr bool PERM = true, AFTER_DRAIN = false;
    float* hmeta; bf16_t* hb; unsigned long long* ssq_out;
    __device__ __forceinline__ void operator()(const f32x4 (&acc)[2][2][4][2], const pg8::Unit& u, int wr, int wc, int fr, int fq) const {
        const int row0 = u.pm * 256 + wr * 64 + fr, col0 = u.pn * 256 + wc * 32 + 8 * fq;
        u32x4 hn[2];
#pragma unroll
        for (int bj = 0; bj < 2; ++bj) hn[bj] = *(const u32x4*)(hb + (size_t)row0 * 1024 + col0 + bj * 128);
#pragma unroll
        for (int g = 0; g < 8; ++g) {
            const int ai = g >> 2, m = g & 3;
            const int row = row0 + ai * 128 + m * 16;
            const size_t off = (size_t)row * 1024 + col0;
            u32x4 hc[2];
#pragma unroll
            for (int bj = 0; bj < 2; ++bj) hc[bj] = hn[bj];
            if (g < 7) {
                const int ai2 = (g + 1) >> 2, m2 = (g + 1) & 3;
                const size_t off2 = (size_t)(row0 + ai2 * 128 + m2 * 16) * 1024 + col0;
#pragma unroll
                for (int bj = 0; bj < 2; ++bj) hn[bj] = *(const u32x4*)(hb + off2 + bj * 128);
            }
            float s = 0.f;
#pragma unroll
            for (int bj = 0; bj < 2; ++bj) {
                const f32x4 r0 = {bflo(hc[bj].x), bfhi(hc[bj].x), bflo(hc[bj].y), bfhi(hc[bj].y)}, r1 = {bflo(hc[bj].z), bfhi(hc[bj].z), bflo(hc[bj].w), bfhi(hc[bj].w)};
                const f32x4 h0 = r0 + acc[ai][bj][m][0], h1 = r1 + acc[ai][bj][m][1];
                u32x4 p; p.x = cvt_pk_bf16(h0.x, h0.y); p.y = cvt_pk_bf16(h0.z, h0.w); p.z = cvt_pk_bf16(h1.x, h1.y); p.w = cvt_pk_bf16(h1.z, h1.w);
                *(u32x4*)(hb + off + bj * 128) = p;
                s += ((h0.x * h0.x + h0.y * h0.y) + (h0.z * h0.z + h0.w * h0.w)) + ((h1.x * h1.x + h1.y * h1.y) + (h1.z * h1.z + h1.w * h1.w));
            }
            s += __shfl_xor(s, 16); s += __shfl_xor(s, 32);
            if (fq == 0) atomicAdd(ssq_out + row, __float2ull_rn(s * SSQ_SCALE));
        }
    }
    __device__ __forceinline__ void meta(int m, int col, f32x4 v) const {
        float* p = hmeta + m * 1024 + col;
        f32x4 h = *(const f32x4*)p + v;
        *(f32x4*)p = h;
        u32x2 q; q.x = cvt_pk_bf16(h.x, h.y); q.y = cvt_pk_bf16(h.z, h.w);
        *(u32x2*)(hb + (size_t)(MROWS + m) * 1024 + col) = q;
        atomicAdd(ssq_out + MROWS + m, __float2ull_rn(((h.x * h.x + h.y * h.y) + (h.z * h.z + h.w * h.w)) * SSQ_SCALE));
    }
};

template <class Epi>
__device__ __forceinline__ void meta_gemm(float* red  , const bf16_t* A, int lda, const bf16_t* Bt, int N, int K, const Epi& E) {
    const int tid = opaque_tid(), wid = tid >> 6, lane = tid & 63, i16 = lane & 15, quad = lane >> 4;
    const int kper = K / 8;
    for (int tile = opaque_bid(); tile < N / 16; tile += gridDim.x) {
        f32x4 acc = {0.f, 0.f, 0.f, 0.f};
        const bf16_t* ap = A + (size_t)i16 * lda + wid * kper + quad * 8;
        const bf16_t* bp = Bt + (size_t)(tile * 16 + i16) * K + wid * kper + quad * 8;
#pragma unroll 16
        for (int k = 0; k < kper; k += 32) {
            const bf16x8 a = *(const bf16x8*)(ap + k), b = *(const bf16x8*)(bp + k);
            acc = __builtin_amdgcn_mfma_f32_16x16x32_bf16(a, b, acc, 0, 0, 0);
        }
#pragma unroll
        for (int j = 0; j < 4; ++j) red[wid * 256 + (quad * 4 + j) * 16 + i16] = acc[j];
        __syncthreads();
        if (tid < 64) {
            const int row = tid >> 2, c4 = (tid & 3) * 4;
            f32x4 s = {0.f, 0.f, 0.f, 0.f};
#pragma unroll
            for (int w = 0; w < 8; ++w) s += *(const f32x4*)(red + w * 256 + row * 16 + c4);
            E.meta(row, tile * 16 + c4, s);
        }
        __syncthreads();
    }
}

__device__ __forceinline__ void conv_w(float* lds, const float* W, int K, int N, bf16_t* WT, const float* gain, int wg, int nwg) {
    const int tid = opaque_tid(), wid = tid >> 6, lane = tid & 63;
    LAS float* scr = (LAS float*)lds + wid * (64 * 33);
    const int nblk = N / 32, nitems = (K / 64) * nblk;
    const int gw = wg * 8 + wid, nw = nwg * 8;
    for (int item = gw; item < nitems; item += nw) {
        const int kb = item / nblk, nb = item % nblk, k0 = 64 * kb, n0 = 32 * nb;
        float v[32];
#pragma unroll
        for (int i = 0; i < 32; ++i) v[i] = W[(size_t)(k0 + 2 * i + (lane >> 5)) * N + n0 + (lane & 31)];
        if (gain) {
#pragma unroll
            for (int i = 0; i < 32; ++i) v[i] *= gain[k0 + 2 * i + (lane >> 5)];
        }
#pragma unroll
        for (int i = 0; i < 32; ++i) scr[(2 * i + (lane >> 5)) * 33 + (lane & 31)] = v[i];
        __builtin_amdgcn_fence(__ATOMIC_RELEASE, "wavefront"); __builtin_amdgcn_wave_barrier(); __builtin_amdgcn_fence(__ATOMIC_ACQUIRE, "wavefront");
        const int c = lane & 7;
#pragma unroll
        for (int j = 0; j < 4; ++j) {
            const int n = (lane >> 3) + 8 * j; const LAS float* s = scr + (8 * c) * 33 + n;
            u32x4 o; o.x = cvt_pk_bf16(s[0 * 33], s[1 * 33]); o.y = cvt_pk_bf16(s[2 * 33], s[3 * 33]); o.z = cvt_pk_bf16(s[4 * 33], s[5 * 33]); o.w = cvt_pk_bf16(s[6 * 33], s[7 * 33]);
            *(u32x4*)(WT + (size_t)(n0 + n) * K + k0 + 8 * c) = o;
        }
        __builtin_amdgcn_fence(__ATOMIC_RELEASE, "wavefront"); __builtin_amdgcn_wave_barrier(); __builtin_amdgcn_fence(__ATOMIC_ACQUIRE, "wavefront");
    }
}

__device__ __forceinline__ void phase_p0(const Params& p) {
    const int tid = opaque_tid(), wid = tid >> 6, lane = tid & 63;
    const int gw = opaque_bid() * 8 + wid, nw = gridDim.x * 8;
    bf16_t* hb = (bf16_t*)(p.ws + WS_HB); unsigned long long* ssq = (unsigned long long*)(p.ws + WS_SSQ); float* hmeta = (float*)(p.ws + WS_HMETA);
    for (int i = opaque_bid() * NTHREADS + tid; i < 8 * RROWS; i += gridDim.x * NTHREADS) ssq[RROWS + i] = 0ull;
    for (int row = gw; row < RROWS; row += 2 * nw) {
        const int row2 = row + nw; const bool two = row2 < RROWS;
        const float* src = row < MROWS ? p.x + (size_t)row * 1024 : p.meta + (size_t)(row - MROWS) * 1024;
        const float* src2 = !two ? src : (row2 < MROWS ? p.x + (size_t)row2 * 1024 : p.meta + (size_t)(row2 - MROWS) * 1024);
        f32x4 v[4], w[4];
#pragma unroll
        for (int j = 0; j < 4; ++j) { v[j] = *(const f32x4*)(src + j * 256 + lane * 4); w[j] = *(const f32x4*)(src2 + j * 256 + lane * 4); }
        float s = 0.f, s2 = 0.f;
#pragma unroll
        for (int j = 0; j < 4; ++j) {
            s += (v[j].x * v[j].x + v[j].y * v[j].y) + (v[j].z * v[j].z + v[j].w * v[j].w);
            u32x2 q; q.x = cvt_pk_bf16(v[j].x, v[j].y); q.y = cvt_pk_bf16(v[j].z, v[j].w);
            *(u32x2*)(hb + (size_t)row * 1024 + j * 256 + lane * 4) = q;
            if (row >= MROWS) *(f32x4*)(hmeta + (size_t)(row - MROWS) * 1024 + j * 256 + lane * 4) = v[j];
            if (two) {
                s2 += (w[j].x * w[j].x + w[j].y * w[j].y) + (w[j].z * w[j].z + w[j].w * w[j].w);
                u32x2 q2; q2.x = cvt_pk_bf16(w[j].x, w[j].y); q2.y = cvt_pk_bf16(w[j].z, w[j].w);
                *(u32x2*)(hb + (size_t)row2 * 1024 + j * 256 + lane * 4) = q2;
                if (row2 >= MROWS) *(f32x4*)(hmeta + (size_t)(row2 - MROWS) * 1024 + j * 256 + lane * 4) = w[j];
            }
        }
        s = sum64(s); s2 = sum64(s2);
        if (lane == 0) { ssq[row] = __float2ull_rn(s * SSQ_SCALE); if (two) ssq[row2] = __float2ull_rn(s2 * SSQ_SCALE); }
    }
}
__device__ __forceinline__ void phase_final(const Params& p) {
    const int tid = opaque_tid(), wid = tid >> 6, lane = tid & 63;
    const int gw = opaque_bid() * 8 + wid, nw = gridDim.x * 8;
    const unsigned long long* ssq = (const unsigned long long*)(p.ws + WS_SSQ) + (size_t)8 * RROWS;
    f32x4 g[4];
#pragma unroll
    for (int j = 0; j < 4; ++j) g[j] = *(const f32x4*)(p.final_norm + j * 256 + lane * 4);
    const bf16_t* hb = (const bf16_t*)(p.ws + WS_HB);
    for (int row = gw; row < MROWS; row += 4 * nw) {
        u32x2 v[4][4]; float rs[4];
#pragma unroll
        for (int r = 0; r < 4; ++r) {
            const int rr = row + r * nw;
            if (rr < MROWS) {
                rs[r] = rsqrtf((float)ssq[rr] * SSQ_INV + 1e-6f);
#pragma unroll
                for (int j = 0; j < 4; ++j) v[r][j] = *(const u32x2*)(hb + (size_t)rr * 1024 + j * 256 + lane * 4);
            }
        }
#pragma unroll
        for (int r = 0; r < 4; ++r) {
            const int rr = row + r * nw;
            if (rr < MROWS) {
#pragma unroll
                for (int j = 0; j < 4; ++j) {
                    const f32x4 h = {bflo(v[r][j].x), bfhi(v[r][j].x), bflo(v[r][j].y), bfhi(v[r][j].y)};
                    *(f32x4*)(p.out + (size_t)rr * 1024 + j * 256 + lane * 4) = h * rs[r] * g[j];
                }
            }
        }
    }
}
constexpr int PP_PS = 0;
constexpr int PS_LD = 1156;
constexpr int PP_ACT = PP_PS + 16 * PS_LD * 4;
constexpr int PP_VA = PP_ACT + 16 * 136 * 2;
constexpr int PP_PART = PP_VA + 16 * 392 * 2;
constexpr int PP_VLO = PP_PART + 6 * 256 * 4;
constexpr int PP_SLB = PP_VLO + 16 * 40 * 2;
constexpr int PP_CST = PP_SLB + 1024;
constexpr int PP_END = PP_CST + 6 * 384 * 4;
static_assert(PP_END <= LDS_BYTES, "prep LDS");
__device__ __forceinline__ bf16x8 ld_bfrag(const float* W, int ldw, int k0, int kmax, int c) {
    float f[8];
#pragma unroll
    for (int e = 0; e < 8; ++e) f[e] = (k0 + e) < kmax ? W[(size_t)(k0 + e) * ldw + c] : 0.f;
    u32x4 o; o.x = cvt_pk_bf16(f[0], f[1]); o.y = cvt_pk_bf16(f[2], f[3]); o.z = cvt_pk_bf16(f[4], f[5]); o.w = cvt_pk_bf16(f[6], f[7]);
    return __builtin_bit_cast(bf16x8, o);
}
__device__ __forceinline__ void phase_prep(const Params& p, unsigned char* ldsb, int l) {
    const int tid = opaque_tid();
    float* ps = (float*)(ldsb + PP_PS);
    bf16_t* act = (bf16_t*)(ldsb + PP_ACT); bf16_t* vA = (bf16_t*)(ldsb + PP_VA);
    float* part = (float*)(ldsb + PP_PART); bf16_t* vloA = (bf16_t*)(ldsb + PP_VLO); float* slb = (float*)(ldsb + PP_SLB);
    bf16_t* proj = (bf16_t*)(p.ws + WS_PROJ);
    bf16_t* PS = (bf16_t*)(p.ws + WS_PS); bf16_t* PV = (bf16_t*)(p.ws + WS_PV); bf16_t* PG = (bf16_t*)(p.ws + WS_PG); bf16_t* VF = (bf16_t*)(p.ws + WS_VF);
    float* BONUS = (float*)(p.ws + WS_BONUS);
    const float* mu = p.b_mu + l * BCOLS;
    if (tid < 256) {
        float v[4], m = -1e30f;
#pragma unroll
        for (int i = 0; i < 4; ++i) { v[i] = p.c_lb[i * 256 + tid]; m = fmaxf(m, v[i]); }
        float den = 0.f, num = 0.f;
#pragma unroll
        for (int i = 0; i < 4; ++i) { const float e = __expf(v[i] - m); den += e; if (i >= 1 && i <= l) num += e; }
        slb[tid] = num / den;
    }
    float* cst = (float*)(ldsb + PP_CST);
    for (int i = tid; i < 6 * 384; i += NTHREADS) {
        const int k = i / 384, c = i % 384;
        const float* src = k == 0 ? p.b_w0 : k == 1 ? p.b_a0 : k == 2 ? p.b_k_k : k == 3 ? p.b_k_a : k == 4 ? p.b_r_k : p.b_v0;
        cst[i] = (k == 5) ? (l > 0 ? src[(l - 1) * 384 + c] : 0.f) : src[l * 384 + c];
    }
    if (tid < 256) vloA[(tid >> 4) * 40 + 16 + (tid & 15)] = 0;
    bf16x8 Bw[4], Ba[4], Bg0[4], Bg1[4], Bv2[4], Bv1[2];
#pragma unroll
    for (int ct = 0; ct < 4; ++ct) { Bw[ct] = Ba[ct] = Bg0[ct] = Bg1[ct] = Bv2[ct] = (bf16x8){0, 0, 0, 0, 0, 0, 0, 0}; }
    Bv1[0] = Bv1[1] = (bf16x8){0, 0, 0, 0, 0, 0, 0, 0};
    const int wid0 = tid >> 6, n160 = tid & 15, quad0 = (tid >> 4) & 3;
    if (wid0 < 6) {
        const float* w2 = p.b_w2 + (size_t)l * 32 * 384; const float* a2 = p.b_a2 + (size_t)l * 32 * 384; const float* g2 = p.b_g2 + (size_t)l * 64 * 384;
#pragma unroll
        for (int ct = 0; ct < 4; ++ct) {
            const int c = wid0 * 64 + (ct >> 1) * 32 + (n160 >> 2) * 8 + (ct & 1) * 4 + (n160 & 3);
            Bw[ct] = ld_bfrag(w2, 384, quad0 * 8, 32, c); Ba[ct] = ld_bfrag(a2, 384, quad0 * 8, 32, c);
            Bg0[ct] = ld_bfrag(g2, 384, quad0 * 8, 64, c); Bg1[ct] = ld_bfrag(g2, 384, 32 + quad0 * 8, 64, c);
            if (l > 0) Bv2[ct] = ld_bfrag(p.b_v2 + (size_t)(l - 1) * 16 * 384, 384, quad0 * 8, 16, c);
        }
        if (l > 0) {
            const float* v1 = p.b_v1 + (size_t)(l - 1) * 384 * 16;
            Bv1[0] = ld_bfrag(v1, 16, wid0 * 64 + quad0 * 8, 384, n160); Bv1[1] = ld_bfrag(v1, 16, wid0 * 64 + 32 + quad0 * 8, 384, n160);
        }
    }
    __syncthreads();
    const int nmain_it = (1024 - opaque_bid() + (int)gridDim.x - 1) / (int)gridDim.x;
    for (int it = 0; it < nmain_it + (opaque_bid() < 6 ? 1 : 0); ++it) {
        const int tile = it < nmain_it ? opaque_bid() + it * (int)gridDim.x : 1024;
        const int hsel = tile == 1024 ? opaque_bid() : -1;
        const int row0 = tile * 16;
        int tidl = tid; asm volatile("" : "+v"(tidl));
        const int wid = tidl >> 6, n16 = tidl & 15, quad = (tidl >> 4) & 3;
        u32x4 cu5[5], pu5[5];
#pragma unroll
        for (int i = 0; i < 5; ++i) {
            const int q = tidl + i * NTHREADS, tok = q / 160, cc = (q % 160) * 8, row = row0 + tok;
            int prow;
            if (tile == 1024) prow = tok == 0 ? -1 : row - 1;
            else prow = (row & (SEQ - 1)) == 0 ? MROWS + NMETA - 1 : row - 1;
            cu5[i] = *(const u32x4*)(proj + (size_t)row * NIN + PC_B + cc);
            pu5[i] = (u32x4){0u, 0u, 0u, 0u};
            if (prow >= 0) pu5[i] = *(const u32x4*)(proj + (size_t)prow * NIN + PC_B + cc);
        }
#pragma unroll
        for (int i = 0; i < 5; ++i) {
            const int q = tidl + i * NTHREADS, tok = q / 160, cc = (q % 160) * 8;
            float c[8], pv[8]; unpack8(cu5[i], c); unpack8(pu5[i], pv);
            const f32x4 m0 = *(const f32x4*)(mu + cc), m1 = *(const f32x4*)(mu + cc + 4);
            float o[8];
            o[0] = c[0] + m0.x * (pv[0] - c[0]); o[1] = c[1] + m0.y * (pv[1] - c[1]); o[2] = c[2] + m0.z * (pv[2] - c[2]); o[3] = c[3] + m0.w * (pv[3] - c[3]);
            o[4] = c[4] + m1.x * (pv[4] - c[4]); o[5] = c[5] + m1.y * (pv[5] - c[5]); o[6] = c[6] + m1.z * (pv[6] - c[6]); o[7] = c[7] + m1.w * (pv[7] - c[7]);
            if (cc < 1152) {
                *(f32x4*)(ps + tok * PS_LD + cc) = (f32x4){o[0], o[1], o[2], o[3]}; *(f32x4*)(ps + tok * PS_LD + cc + 4) = (f32x4){o[4], o[5], o[6], o[7]};
                if (cc >= 768) { u32x4 b; b.x = cvt_pk_bf16(o[0], o[1]); b.y = cvt_pk_bf16(o[2], o[3]); b.z = cvt_pk_bf16(o[4], o[5]); b.w = cvt_pk_bf16(o[6], o[7]); *(u32x4*)(vA + tok * 392 + (cc - 768)) = b; }
            } else {
                if (cc < 1184) {
#pragma unroll
                    for (int e = 0; e < 8; ++e) o[e] = tanhf_(o[e]);
                } else if (cc >= 1216) {
#pragma unroll
                    for (int e = 0; e < 8; ++e) o[e] = sigmoidf_(o[e]);
                }
                u32x4 b; b.x = cvt_pk_bf16(o[0], o[1]); b.y = cvt_pk_bf16(o[2], o[3]); b.z = cvt_pk_bf16(o[4], o[5]); b.w = cvt_pk_bf16(o[6], o[7]);
                *(u32x4*)(act + tok * 136 + (cc - 1152)) = b;
            }
            asm volatile("" ::: "memory");
        }
        __syncthreads();
        if (l > 0) {
            if (wid < 6) {
                const bf16x8 a0 = *(const bf16x8*)(vA + n16 * 392 + wid * 64 + quad * 8), a1 = *(const bf16x8*)(vA + n16 * 392 + wid * 64 + 32 + quad * 8);
                f32x4 acc = {0.f, 0.f, 0.f, 0.f};
                acc = __builtin_amdgcn_mfma_f32_16x16x32_bf16(Bv1[0], a0, acc, 0, 0, 0);
                acc = __builtin_amdgcn_mfma_f32_16x16x32_bf16(Bv1[1], a1, acc, 0, 0, 0);
                *(f32x4*)(part + wid * 256 + n16 * 16 + quad * 4) = acc;
            }
            __syncthreads();
            if (tidl < 256) {
                float s = 0.f;
#pragma unroll
                for (int w = 0; w < 6; ++w) s += part[w * 256 + tidl];
                vloA[(tidl >> 4) * 40 + (tidl & 15)] = f2bf(s);
            }
            __syncthreads();
        }
        if (wid < 6 && (hsel < 0 || wid == hsel)) {
            const int h = wid, tok = n16; const unsigned row = (unsigned)(row0 + tok);
            const bf16x8 aw = *(const bf16x8*)(act + n16 * 136 + quad * 8), aa = *(const bf16x8*)(act + n16 * 136 + 32 + quad * 8);
            const bf16x8 ag0 = *(const bf16x8*)(act + n16 * 136 + 64 + quad * 8), ag1 = *(const bf16x8*)(act + n16 * 136 + 96 + quad * 8);
            const bf16x8 av = *(const bf16x8*)(vloA + n16 * 40 + quad * 8);
            float ssq = 0.f, bon = 0.f;
#pragma unroll
            for (int ct = 0; ct < 4; ++ct) {
                const int c = h * 64 + (ct >> 1) * 32 + quad * 8 + (ct & 1) * 4;
                const f32x4 kr = *(const f32x4*)(ps + tok * PS_LD + 384 + c) * *(const f32x4*)(cst + 768 + c);
                ssq += (kr.x * kr.x + kr.y * kr.y) + (kr.z * kr.z + kr.w * kr.w);
            }
            ssq += __shfl_xor(ssq, 16); ssq += __shfl_xor(ssq, 32);
            const float inv = 1.f / fmaxf(sqrtf(ssq), 1e-12f);
            u32x2 e_omw = {0u, 0u}, e_kmod = {0u, 0u}, e_rp = {0u, 0u}, e_v = {0u, 0u}, e_g = {0u, 0u}, e_kk = {0u, 0u}, e_ka = {0u, 0u};
            u32x2 vfr4[4];
#pragma unroll
            for (int ct = 0; ct < 4; ++ct) { vfr4[ct] = (u32x2){0u, 0u}; if (l > 0) vfr4[ct] = *(const u32x2*)(VF + row * 384 + h * 64 + (ct >> 1) * 32 + quad * 8 + (ct & 1) * 4); }
            bf16_t* psrow = PS + (row * 6 + h) * 256;
            float* wtl = p.out + WTL_F + ((size_t)tile * 6 + h) * 64;
#pragma unroll
            for (int ct = 0; ct < 4; ++ct) {
                int c = h * 64 + (ct >> 1) * 32 + quad * 8 + (ct & 1) * 4; asm volatile("" : "+v"(c));
                const int cl = (ct >> 1) * 32 + quad * 8;
                const f32x4 z = {0.f, 0.f, 0.f, 0.f};
                const f32x4 cw = __builtin_amdgcn_mfma_f32_16x16x32_bf16(Bw[ct], aw, z, 0, 0, 0);
                const f32x4 ca = __builtin_amdgcn_mfma_f32_16x16x32_bf16(Ba[ct], aa, z, 0, 0, 0);
                f32x4 cg = __builtin_amdgcn_mfma_f32_16x16x32_bf16(Bg0[ct], ag0, z, 0, 0, 0);
                cg = __builtin_amdgcn_mfma_f32_16x16x32_bf16(Bg1[ct], ag1, cg, 0, 0, 0);
                f32x4 cv = z;
                if (l > 0) cv = __builtin_amdgcn_mfma_f32_16x16x32_bf16(Bv2[ct], av, z, 0, 0, 0);
                const f32x4 w0 = *(const f32x4*)(cst + c), a0 = *(const f32x4*)(cst + 384 + c), kk_ = *(const f32x4*)(cst + 768 + c);
                const f32x4 ka_ = *(const f32x4*)(cst + 1152 + c), rk_ = *(const f32x4*)(cst + 1536 + c), v0 = *(const f32x4*)(cst + 1920 + c);
                const f32x4 rp = *(const f32x4*)(ps + tok * PS_LD + c), kp = *(const f32x4*)(ps + tok * PS_LD + 384 + c), vp = *(const f32x4*)(ps + tok * PS_LD + 768 + c);
                f32x4 omw, a, v = vp;
#pragma unroll
                for (int j = 0; j < 4; ++j) {
                    const float x = w0[j] + cw[j];
                    const float sp = fmaxf(-x, 0.f) + __logf(1.f + __expf(-fabsf(x)));
                    omw[j] = 1.f - __expf(-__expf(-sp - 0.5f));
                    a[j] = sigmoidf_(a0[j] + ca[j]);
                }
                if (l == 0) { u32x2 o; o.x = cvt_pk_bf16(vp.x, vp.y); o.y = cvt_pk_bf16(vp.z, vp.w); *(u32x2*)(VF + row * 384 + c) = o; }
                else {
                    const u32x2 vfr = vfr4[ct];
                    const f32x4 vf = {bflo(vfr.x), bfhi(vfr.x), bflo(vfr.y), bfhi(vfr.y)};
#pragma unroll
                    for (int j = 0; j < 4; ++j) v[j] = vp[j] + (vf[j] - vp[j]) * sigmoidf_(v0[j] + cv[j]);
                }
                const f32x4 kmod0 = kp * (1.f + (a - 1.f) * ka_);
                const f32x4 kr = kp * kk_;
                const f32x4 kk0 = kr * inv, kka0 = kk0 * a;
                const f32x4 bt = rp * kmod0 * rk_;
                bon += (bt.x + bt.y) + (bt.z + bt.w);
                f32x4 W, Wp;
#pragma unroll
                for (int j = 0; j < 4; ++j) {
                    float x = 1.f - omw[j];
                    x *= dppf1<0x111>(x); x *= dppf1<0x112>(x); x *= dppf1<0x114>(x); x *= dppf1<0x118>(x);
                    W[j] = x; Wp[j] = dppf1<0x111>(x);
                }
                f32x4 Wi; Wi.x = rcpf_(W.x); Wi.y = rcpf_(W.y); Wi.z = rcpf_(W.z); Wi.w = rcpf_(W.w);
                const f32x4 kk = kk0 * Wp, kka = kka0 * Wi, kmod = kmod0 * Wi, rps = rp * W;
                omw = W;
                u32x2 o_omw, o_kmod, o_rp, o_v, o_g, o_kk, o_ka;
                o_kk.x = cvt_pk_bf16(kk.x, kk.y); o_kk.y = cvt_pk_bf16(kk.z, kk.w); o_ka.x = cvt_pk_bf16(kka.x, kka.y); o_ka.y = cvt_pk_bf16(kka.z, kka.w);
                o_omw.x = cvt_pk_bf16(omw.x, omw.y); o_omw.y = cvt_pk_bf16(omw.z, omw.w);
                o_kmod.x = cvt_pk_bf16(kmod.x, kmod.y); o_kmod.y = cvt_pk_bf16(kmod.z, kmod.w);
                o_rp.x = cvt_pk_bf16(rps.x, rps.y); o_rp.y = cvt_pk_bf16(rps.z, rps.w);
                o_v.x = cvt_pk_bf16(v.x, v.y); o_v.y = cvt_pk_bf16(v.z, v.w);
                o_g.x = cvt_pk_bf16(cg.x, cg.y); o_g.y = cvt_pk_bf16(cg.z, cg.w);
                if (tok == 15) *(f32x4*)(wtl + cl + (ct & 1) * 4) = W;
                if ((ct & 1) == 0) { e_omw = o_omw; e_kmod = o_kmod; e_rp = o_rp; e_v = o_v; e_g = o_g; e_kk = o_kk; e_ka = o_ka; }
                else {
                    *(u32x4*)(psrow + 0 + cl) = (u32x4){e_kk.x, e_kk.y, o_kk.x, o_kk.y};
                    *(u32x4*)(psrow + 64 + cl) = (u32x4){e_ka.x, e_ka.y, o_ka.x, o_ka.y};
                    *(u32x4*)(psrow + 128 + cl) = (u32x4){e_kmod.x, e_kmod.y, o_kmod.x, o_kmod.y};
                    *(u32x4*)(psrow + 192 + cl) = (u32x4){e_rp.x, e_rp.y, o_rp.x, o_rp.y};
                    *(u32x4*)(PV + row * 384 + h * 64 + cl) = (u32x4){e_v.x, e_v.y, o_v.x, o_v.y};
                    *(u32x4*)(PG + row * 384 + h * 64 + cl) = (u32x4){e_g.x, e_g.y, o_g.x, o_g.y};
                }
                asm volatile("" ::: "memory");
                __builtin_amdgcn_sched_barrier(0);
            }
            bon += __shfl_xor(bon, 16); bon += __shfl_xor(bon, 32);
            if (quad == 0) BONUS[row * 8 + h] = bon;
        } else if (wid >= 6 && hsel <= 0) {
            const int t2 = tidl - 384, tok = t2 & 15, g = t2 >> 4;
            bf16_t* rowp = proj + (size_t)(row0 + tok) * NIN;
            float* acb = p.out + ACB_F + (size_t)tile * 256;
            u32x4 rq[4], rf[4];
#pragma unroll
            for (int i = 0; i < 4; ++i) { rq[i] = *(const u32x4*)(rowp + PC_Q + g * 32 + i * 8); rf[i] = *(const u32x4*)(rowp + PC_FZ + g * 32 + i * 8); }
#pragma unroll
            for (int i = 0; i < 4; ++i) {
                float fq_[8], ff_[8]; unpack8(rq[i], fq_); unpack8(rf[i], ff_);
#pragma unroll
                for (int e = 0; e < 8; ++e) {
                    const int c = g * 32 + i * 8 + e;
                    const float lb = slb[c];
                    const float kk = (1.f - lb) * (1.f - sigmoidf_(ff_[e]));
                    float a_ = 1.f - kk;
                    a_ *= dppf1<0x111>(a_); a_ *= dppf1<0x112>(a_); a_ *= dppf1<0x114>(a_); a_ *= dppf1<0x118>(a_);
                    a_ = fmaxf(a_, 1e-30f);
                    if (tok == 15) acb[c] = a_;
                    fq_[e] = siluf_(fq_[e]) * a_;
                    ff_[e] = kk * rcpf_(a_);
                }
                u32x4 o; o.x = cvt_pk_bf16(fq_[0], fq_[1]); o.y = cvt_pk_bf16(fq_[2], fq_[3]); o.z = cvt_pk_bf16(fq_[4], fq_[5]); o.w = cvt_pk_bf16(fq_[6], fq_[7]);
                *(u32x4*)(rowp + PC_Q + g * 32 + i * 8) = o;
                o.x = cvt_pk_bf16(ff_[0], ff_[1]); o.y = cvt_pk_bf16(ff_[2], ff_[3]); o.z = cvt_pk_bf16(ff_[4], ff_[5]); o.w = cvt_pk_bf16(ff_[6], ff_[7]);
                *(u32x4*)(rowp + PC_FZ + g * 32 + i * 8) = o;
            }
        }
        __syncthreads();
    }
}
constexpr int SB_TOK = 256, SB_BUF = 16 * SB_TOK;
constexpr int SC_TOK = 128, SC_BUF = 16 * SC_TOK;
template <int VAR, int MODE = 0>
__device__ __forceinline__ void scan_bc(const Params& p, float* lds, int slot, int l) {
    const int tid = opaque_tid(), half = tid >> 8, t2 = tid & 255, r = t2 >> 4, ks = t2 & 15;
    float* sb = lds;
    float* sv = sb + 2 * SB_BUF;
    float* sy = sv + 2 * 256;
    float* swd = sy + 2 * 256;
    float* sc = sy + 2 * 256;
    float* si = sc + 2 * SC_BUF;
    float* so = si + 2 * 256;
    float* slb = so + 2 * 256;
    const bf16_t* proj = (const bf16_t*)(p.ws + WS_PROJ);
    float* projf = (float*)(p.ws + WS_PROJ);
    const bf16_t* PS = (const bf16_t*)(p.ws + WS_PS); const bf16_t* PV = (const bf16_t*)(p.ws + WS_PV);
    float* YRAW = p.out;
    const int bb = (slot >> 2) / 6, bh = (slot >> 2) % 6, rg = slot & 3;
    const int cunit = slot * 2 + half;
    const bool hasc = (VAR == 0) && (MODE == 1) && cunit < 32;
    const int cb = cunit >> 2, ch = cunit & 3, vg = t2 >> 6, cl_ = t2 & 63, cn = cl_ & 15, cq4 = cl_ >> 4;
    bf16_t* cbase = (bf16_t*)((unsigned char*)lds + half * 45056);
    constexpr int QLD = 72, VLD = 40, CQP = 0, CKP = 16 * QLD, CIP = 2 * 16 * QLD, CKH = CIP + 64 * VLD, CIV = CKH + 64 * VLD, CAC = CIV + 64 * VLD, CB_EL = CAC + 128;
    const int ub = MODE == 0 ? bb : cb;
    if (hasc) { for (int i = t2; i < 2 * CB_EL / 8; i += 256) *(u32x4*)(cbase + i * 8) = (u32x4){0u, 0u, 0u, 0u}; }
    __syncthreads();
    u32x4 preA[3]; u32x4 prevA = {0u, 0u, 0u, 0u}; u32x4 preK[2] = {{0u, 0u, 0u, 0u}, {0u, 0u, 0u, 0u}};
    f32x4 cS[4] = {{0.f, 0.f, 0.f, 0.f}, {0.f, 0.f, 0.f, 0.f}, {0.f, 0.f, 0.f, 0.f}, {0.f, 0.f, 0.f, 0.f}};
    f32x2 Sa = {0.f, 0.f}, Sb = {0.f, 0.f};
#define SCAN_ROW(tile, tok) ((tile) == 0 ? MROWS + (tok) : ub * SEQ + ((tile) - 1) * 16 + (tok))
    auto issue = [&](int tile, u32x4 (&pre)[3], u32x4& prev_) __attribute__((always_inline)) {
        if (MODE == 0 && half == 0) {
#pragma unroll
            for (int i = 0; i < 2; ++i) { const int q = t2 + i * 256, tok = q >> 5, w = q & 31; pre[i] = *(const u32x4*)(PS + ((size_t)SCAN_ROW(tile, tok) * 6 + bh) * 256 + w * 8); }
            if (t2 < 48) {
                const int tok = t2 >> 1, h8 = t2 & 1, tgl = tile == 0 ? 1024 : bb * 128 + tile - 1;
                const void* src = t2 < 32 ? (const void*)(PV + (size_t)SCAN_ROW(tile, tok & 15) * 384 + bh * 64 + rg * 16 + h8 * 8) : (const void*)(p.out + WTL_F + ((size_t)tgl * 6 + bh) * 64 + (t2 - 32) * 4);
                prev_ = *(const u32x4*)src;
            }
        } else if (hasc) {
            const int tgl = tile == 0 ? 1024 : cb * 128 + tile - 1;
#pragma unroll
            for (int i = 0; i < 2; ++i) {
                const int q = t2 + i * 256;
                if (q < 384) {
                    const int kind = q >> 7, j = q & 127, tok = j & 15, part = j >> 4;
                    const int col = (kind == 0 ? PC_Q : (kind == 1 ? PC_FZ : PC_I)) + ch * 64 + part * 8;
                    pre[i] = *(const u32x4*)(proj + (size_t)SCAN_ROW(tile, tok) * NIN + col);
                    if (kind == 1) { const float* ac = p.out + ACB_F + (size_t)tgl * 256 + ch * 64 + part * 8; preK[0] = *(const u32x4*)ac; preK[1] = *(const u32x4*)(ac + 4); }
                } else if (q < 400) {
                    pre[i] = *(const u32x4*)(p.out + ACB_F + (size_t)tgl * 256 + ch * 64 + (q - 384) * 4);
                }
            }
        }
    };
    auto commit = [&](int buf, u32x4 (&pre)[3], u32x4& prev_) __attribute__((always_inline)) {
        if (MODE == 0 && half == 0) {
#pragma unroll
            for (int i = 0; i < 2; ++i) {
                const int q = t2 + i * 256, tok = q >> 5, w = q & 31; float f[8]; unpack8(pre[i], f);
                if (w >= 8 && w < 16) {
#pragma unroll
                    for (int e = 0; e < 8; ++e) f[e] = -f[e];
                }
                float* d = sb + buf * SB_BUF + tok * SB_TOK + w * 8;
                *(f32x4*)d = (f32x4){f[0], f[1], f[2], f[3]}; *(f32x4*)(d + 4) = (f32x4){f[4], f[5], f[6], f[7]};
            }
            if (t2 < 32) {
                const int tok = t2 >> 1, h8 = t2 & 1; float f[8]; unpack8(prev_, f);
                float* d = sv + buf * 256 + tok * 16 + h8 * 8;
                *(f32x4*)d = (f32x4){f[0], f[1], f[2], f[3]}; *(f32x4*)(d + 4) = (f32x4){f[4], f[5], f[6], f[7]};
            } else if (t2 < 48) {
                *(u32x4*)(swd + buf * 64 + (t2 - 32) * 4) = prev_;
            }
        } else if (hasc) {
            bf16_t* cb_ = cbase + buf * CB_EL;
#pragma unroll
            for (int i = 0; i < 2; ++i) {
                const int q = t2 + i * 256;
                if (q < 384) {
                    const int kind = q >> 7, j = q & 127, tok = j & 15, part = j >> 4;
                    if (kind < 2) {
                        const int kt = part >> 1, s2 = kt >> 1, e0 = (kt & 1) * 4, q0 = (part & 1) * 2;
                        bf16_t* d = cb_ + (kind == 0 ? CQP : CKP) + tok * QLD + (s2 * 4 + q0) * 8 + e0;
                        *(u32x2*)d = (u32x2){pre[i].x, pre[i].y}; *(u32x2*)(d + 8) = (u32x2){pre[i].z, pre[i].w};
                        if (kind == 1) {
                            float f[8]; unpack8(pre[i], f);
                            const f32x4 a0 = __builtin_bit_cast(f32x4, preK[0]), a1 = __builtin_bit_cast(f32x4, preK[1]);
                            const float ac[8] = {a0.x, a0.y, a0.z, a0.w, a1.x, a1.y, a1.z, a1.w};
#pragma unroll
                            for (int e = 0; e < 8; ++e) cb_[CKH + (part * 8 + e) * VLD + (tok >> 3) * 8 + (tok & 7)] = f2bf(f[e] * ac[e]);
                        }
                    } else {
                        const unsigned short h8[8] = {(unsigned short)(pre[i].x & 0xffffu), (unsigned short)(pre[i].x >> 16), (unsigned short)(pre[i].y & 0xffffu), (unsigned short)(pre[i].y >> 16),
                                                      (unsigned short)(pre[i].z & 0xffffu), (unsigned short)(pre[i].z >> 16), (unsigned short)(pre[i].w & 0xffffu), (unsigned short)(pre[i].w >> 16)};
#pragma unroll
                        for (int e = 0; e < 8; ++e) {
                            const int v = part * 8 + e;
                            cb_[CIP + v * VLD + (tok >> 2) * 8 + (tok & 3)] = h8[e];
                            cb_[CIV + v * VLD + (tok >> 3) * 8 + (tok & 7)] = h8[e];
                        }
                    }
                } else if (q < 400) {
                    *(u32x4*)(cb_ + CAC + (q - 384) * 8) = pre[i];
                }
            }
        }
    };
    issue(0, preA, prevA); commit(0, preA, prevA);
    __syncthreads();
    for (int tile = 0; tile < 129; ++tile) {
        const int buf = tile & 1;
        if (VAR != 4 && tile + 1 < 129) issue(tile + 1, preA, prevA);
        if (MODE == 0 && half == 0) {
            const float* T = sb + buf * SB_BUF + ks * 4;
            const float* V = sv + buf * 256 + r;
            f32x4 rkk[3], rka[3], rkx[3], rrr[3]; float rv[3];
            const f32x4 wend = *(const f32x4*)(swd + buf * 64 + ks * 4);
#pragma unroll
            for (int i = 0; i < 2; ++i) { const float* Tn = T + i * SB_TOK; rkk[i] = *(const f32x4*)(Tn); rka[i] = *(const f32x4*)(Tn + 64); rkx[i] = *(const f32x4*)(Tn + 128); rrr[i] = *(const f32x4*)(Tn + 192); rv[i] = V[i * 16]; }
            float ykeep = 0.f, yp = 0.f;
#pragma unroll
            for (int tok = 0; tok < 16; ++tok) {
                const int cs = tok % 3, ns = (tok + 2) % 3;
                if (tok < 14) {
                    const float* Tn = T + (tok + 2) * SB_TOK;
                    if (VAR != 3) { rkk[ns] = *(const f32x4*)(Tn); rka[ns] = *(const f32x4*)(Tn + 64); rkx[ns] = *(const f32x4*)(Tn + 128); rrr[ns] = *(const f32x4*)(Tn + 192);
                    rv[ns] = V[(tok + 2) * 16]; }
                }
                const f32x4 kk = rkk[cs], nk_ = rka[cs], kx = rkx[cs], rr = rrr[cs]; const float vv = rv[cs];
                f32x2 P = Sa * kk.xy; P = Sb * kk.zw + P;
                float d = P.x + P.y;
                const f32x2 Ta = vv * kx.xy + Sa, Tb = vv * kx.zw + Sb;
                if (VAR != 2) d = sum16(d);
                if (tok > 0) { const float y = (VAR != 2) ? sum16(yp) : yp; ykeep = (ks == tok - 1) ? y : ykeep; }
                Sa = d * nk_.xy + Ta; Sb = d * nk_.zw + Tb;
                f32x2 Q = Sa * rr.xy; Q = Sb * rr.zw + Q;
                yp = Q.x + Q.y;
            }
            { const float y = sum16(yp); ykeep = (ks == 15) ? y : ykeep; }
            Sa = Sa * wend.xy; Sb = Sb * wend.zw;
            sy[buf * 256 + ks * 16 + r] = ykeep;
        } else if (hasc) {
            const bf16_t* cb_ = cbase + buf * CB_EL;
            const bf16x8 qf0 = *(const bf16x8*)(cb_ + CQP + cn * QLD + (0 * 4 + cq4) * 8), qf1 = *(const bf16x8*)(cb_ + CQP + cn * QLD + (1 * 4 + cq4) * 8);
            const bf16x8 kf0 = *(const bf16x8*)(cb_ + CKP + cn * QLD + (0 * 4 + cq4) * 8), kf1 = *(const bf16x8*)(cb_ + CKP + cn * QLD + (1 * 4 + cq4) * 8);
            const bf16x8 ipf = *(const bf16x8*)(cb_ + CIP + (vg * 16 + cn) * VLD + cq4 * 8), ivf = *(const bf16x8*)(cb_ + CIV + (vg * 16 + cn) * VLD + cq4 * 8);
            u32x4 sp;
            sp.x = cvt_pk_bf16(cS[0].x, cS[0].y); sp.y = cvt_pk_bf16(cS[0].z, cS[0].w); sp.z = cvt_pk_bf16(cS[1].x, cS[1].y); sp.w = cvt_pk_bf16(cS[1].z, cS[1].w);
            const bf16x8 sf0 = __builtin_bit_cast(bf16x8, sp);
            sp.x = cvt_pk_bf16(cS[2].x, cS[2].y); sp.y = cvt_pk_bf16(cS[2].z, cS[2].w); sp.z = cvt_pk_bf16(cS[3].x, cS[3].y); sp.w = cvt_pk_bf16(cS[3].z, cS[3].w);
            const bf16x8 sf1 = __builtin_bit_cast(bf16x8, sp);
            f32x4 o = {0.f, 0.f, 0.f, 0.f}, att = {0.f, 0.f, 0.f, 0.f};
            o = __builtin_amdgcn_mfma_f32_16x16x32_bf16(sf0, qf0, o, 0, 0, 0);
            o = __builtin_amdgcn_mfma_f32_16x16x32_bf16(sf1, qf1, o, 0, 0, 0);
            att = __builtin_amdgcn_mfma_f32_16x16x32_bf16(kf0, qf0, att, 0, 0, 0);
            att = __builtin_amdgcn_mfma_f32_16x16x32_bf16(kf1, qf1, att, 0, 0, 0);
            att.x = (4 * cq4 + 0 <= cn) ? att.x : 0.f; att.y = (4 * cq4 + 1 <= cn) ? att.y : 0.f; att.z = (4 * cq4 + 2 <= cn) ? att.z : 0.f; att.w = (4 * cq4 + 3 <= cn) ? att.w : 0.f;
            sp.x = cvt_pk_bf16(att.x, att.y); sp.y = cvt_pk_bf16(att.z, att.w); sp.z = 0u; sp.w = 0u;
            o = __builtin_amdgcn_mfma_f32_16x16x32_bf16(ipf, __builtin_bit_cast(bf16x8, sp), o, 0, 0, 0);
            if (tile > 0 || cb == 0) *(f32x4*)(projf + (size_t)SCAN_ROW(tile, cn) * 1536 + ORAW_F + ch * 64 + vg * 16 + 4 * cq4) = o;
            const float* acs = (const float*)(cb_ + CAC);
#pragma unroll
            for (int kt = 0; kt < 4; ++kt) {
                const f32x4 ac = *(const f32x4*)(acs + 16 * kt + 4 * cq4);
                const bf16x8 khf = *(const bf16x8*)(cb_ + CKH + (16 * kt + cn) * VLD + cq4 * 8);
                cS[kt] = __builtin_amdgcn_mfma_f32_16x16x32_bf16(khf, ivf, cS[kt] * ac, 0, 0, 0);
            }
        }
        if (VAR != 4 && tile + 1 < 129) commit(buf ^ 1, preA, prevA);
        __syncthreads();
        if (VAR == 0 && MODE == 0 && half == 0 && t2 < 64 && (tile > 0 || ub == 0)) {
            const int tok = t2 >> 2, q4 = (t2 & 3) * 4, row = SCAN_ROW(tile, tok);
            if (half == 0) *(f32x4*)(YRAW + (size_t)row * 384 + bh * 64 + rg * 16 + q4) = *(const f32x4*)(sy + buf * 256 + tok * 16 + q4);
        }
    }
#undef SCAN_ROW
    __syncthreads();
}
__device__ __forceinline__ void scan_a(const Params& p, unsigned char* ldsb, int ua, int l) {
    const int tid = opaque_tid(), wid = tid >> 6, lane = tid & 63;
    const int b = ua / 6, ha = ua % 6, c0 = ha * 64;
    float* xs = (float*)ldsb;
    float* gs = xs + 67 * 64;
    float* us = gs + 64 * 64;
    float* gt = us + 64 * 64;
    float* seg = gt + 64 * 132;
    float* hc = seg + 8 * 64 * 2;
    bf16_t* ub = (bf16_t*)(hc + 128);
    bf16_t* wt = ub + 64 * 72;
    bf16_t* proj = (bf16_t*)(p.ws + WS_PROJ); bf16_t* ymeta = (bf16_t*)(p.ws + WS_YMETA);
    const int c = tid & 63, tg = tid >> 6;
    const float cw0 = p.a_conv_w[(l * 4 + 0) * 384 + c0 + c], cw1 = p.a_conv_w[(l * 4 + 1) * 384 + c0 + c], cw2 = p.a_conv_w[(l * 4 + 2) * 384 + c0 + c], cw3 = p.a_conv_w[(l * 4 + 3) * 384 + c0 + c];
    const float cbias = p.a_conv_b[l * 384 + c0 + c], br = p.a_b_r[l * 384 + c0 + c], bi = p.a_b_i[l * 384 + c0 + c];
    const float spl8 = 8.f * softplusf_(-p.a_lambda[l * 384 + c0 + c]);
    {
        const float* wr_ = p.a_w_r + ((size_t)(l * 6 + ha)) * 4096; const float* wi_ = p.a_w_i + ((size_t)(l * 6 + ha)) * 4096;
        for (int q = tid; q < 8192; q += NTHREADS) {
            const int g = q >> 12, k = (q >> 6) & 63, n = q & 63;
            wt[(g * 64 + n) * 72 + k] = f2bf(g ? wi_[k * 64 + n] : wr_[k * 64 + n]);
        }
        if (tid < 192) xs[tid] = 0.f;
        if (tid < 128) hc[tid] = 0.f;
    }
    __syncthreads();
    bf16x8 bfr[2];
    {
        const int n = lane & 15, quad = lane >> 4;
        bfr[0] = *(const bf16x8*)(wt + (wid * 16 + n) * 72 + quad * 8);
        bfr[1] = *(const bf16x8*)(wt + (wid * 16 + n) * 72 + 32 + quad * 8);
    }
    u32x4 px = {0u, 0u, 0u, 0u}, pg = {0u, 0u, 0u, 0u};
    const int ltok = tid >> 3, lc8 = (tid & 7) * 8;
#define A_ROW(tile, tok) ((tile) == 0 ? MROWS + (tok) : b * SEQ + ((tile) - 1) * 64 + (tok))
#define A_NTOK(tile) ((tile) == 0 ? 16 : 64)
    if (ltok < A_NTOK(0)) { const size_t ro = (size_t)A_ROW(0, ltok) * NIN; px = *(const u32x4*)(proj + ro + PC_XA + c0 + lc8); pg = *(const u32x4*)(proj + ro + PC_GA + c0 + lc8); }
    for (int tile = 0; tile < 33; ++tile) {
        const int ntok = A_NTOK(tile), cur = tile & 1;
        {
            float f[8]; unpack8(px, f);
            *(f32x4*)(xs + (3 + ltok) * 64 + lc8) = (f32x4){f[0], f[1], f[2], f[3]}; *(f32x4*)(xs + (3 + ltok) * 64 + lc8 + 4) = (f32x4){f[4], f[5], f[6], f[7]};
            unpack8(pg, f);
            *(f32x4*)(gs + ltok * 64 + lc8) = (f32x4){f[0], f[1], f[2], f[3]}; *(f32x4*)(gs + ltok * 64 + lc8 + 4) = (f32x4){f[4], f[5], f[6], f[7]};
        }
        __syncthreads();
        if (tile + 1 < 33 && ltok < A_NTOK(tile + 1)) { const size_t ro = (size_t)A_ROW(tile + 1, ltok) * NIN; px = *(const u32x4*)(proj + ro + PC_XA + c0 + lc8); pg = *(const u32x4*)(proj + ro + PC_GA + c0 + lc8); }
#pragma unroll
        for (int i = 0; i < 8; ++i) {
            const int tok = tg * 8 + i;
            const float u = cbias + cw0 * xs[tok * 64 + c] + cw1 * xs[(tok + 1) * 64 + c] + cw2 * xs[(tok + 2) * 64 + c] + cw3 * xs[(tok + 3) * 64 + c];
            us[tok * 64 + c] = u; ub[tok * 72 + c] = f2bf(u);
        }
        __syncthreads();
        {
            const int m = lane & 15, quad = lane >> 4;
#pragma unroll
            for (int mb = 0; mb < 4; ++mb) {
                const bf16x8 a0 = *(const bf16x8*)(ub + (mb * 16 + m) * 72 + quad * 8), a1 = *(const bf16x8*)(ub + (mb * 16 + m) * 72 + 32 + quad * 8);
                f32x4 acc = {0.f, 0.f, 0.f, 0.f};
                acc = __builtin_amdgcn_mfma_f32_16x16x32_bf16(a0, bfr[0], acc, 0, 0, 0);
                acc = __builtin_amdgcn_mfma_f32_16x16x32_bf16(a1, bfr[1], acc, 0, 0, 0);
#pragma unroll
                for (int j = 0; j < 4; ++j) gt[(mb * 16 + quad * 4 + j) * 132 + wid * 16 + m] = acc[j];
            }
        }
        __syncthreads();
        {
            float Ap = 1.f, hl = 0.f;
#pragma unroll
            for (int i = 0; i < 8; ++i) {
                const int tok = tg * 8 + i;
                float a = 1.f, dr = 0.f;
                if (tok < ntok) {
                    const float rr = sigmoidf_(gt[tok * 132 + c] + br), ii = sigmoidf_(gt[tok * 132 + 64 + c] + bi);
                    const float la = -rr * spl8;
                    a = __expf(la);
                    dr = sqrtf(fmaxf(1.f - a * a, 0.f)) * (ii * us[tok * 64 + c]);
                }
                hl = a * hl + dr; Ap *= a;
                gt[tok * 132 + c] = hl; gt[tok * 132 + 64 + c] = Ap;
            }
            seg[(tg * 64 + c) * 2] = Ap; seg[(tg * 64 + c) * 2 + 1] = hl;
        }
        float hist = 0.f;
        if (tid < 192) hist = xs[(ntok + (tid >> 6)) * 64 + c];
        __syncthreads();
        if (tid < 192) xs[(tid >> 6) * 64 + c] = hist;
        {
            float carry = hc[cur * 64 + c];
            for (int s = 0; s < tg; ++s) carry = seg[(s * 64 + c) * 2] * carry + seg[(s * 64 + c) * 2 + 1];
            float hlast = carry;
#pragma unroll
            for (int i = 0; i < 8; ++i) {
                const int tok = tg * 8 + i;
                const float h = gt[tok * 132 + c] + gt[tok * 132 + 64 + c] * carry;
                hlast = h;
                if (tok < ntok) {
                    const float y = h * geluf_(gs[tok * 64 + c]);
                    if (tile > 0) proj[(size_t)A_ROW(tile, tok) * NIN + PC_YA + c0 + c] = f2bf(y);
                    else if (b == 0) ymeta[tok * 1024 + c0 + c] = f2bf(y);
                }
            }
            if (tg == 7) hc[(cur ^ 1) * 64 + c] = hlast;
        }
        __syncthreads();
    }
#undef A_ROW
#undef A_NTOK
}
__device__ __forceinline__ void phase_post(const Params& p, int l) {
    const int tid = opaque_tid(), wid = tid >> 6, lane = tid & 63;
    const int gw = opaque_bid() * 8 + wid, nw = gridDim.x * 8;
    bf16_t* proj = (bf16_t*)(p.ws + WS_PROJ); const float* projf = (const float*)(p.ws + WS_PROJ);
    const float* YRAW = p.out;
    const bf16_t* PV = (const bf16_t*)(p.ws + WS_PV); const bf16_t* PG = (const bf16_t*)(p.ws + WS_PG);
    const float* BONUS = (const float*)(p.ws + WS_BONUS);
    bf16_t* ymeta = (bf16_t*)(p.ws + WS_YMETA);
    float yb[6], pv[6], pg[6], oc[4], og[4], bonl;
    auto load_row = [&](int row, float (&yb_)[6], float (&pv_)[6], float (&pg_)[6], float (&oc_)[4], float (&og_)[4], float& bonl_) __attribute__((always_inline)) {
#pragma unroll
        for (int h = 0; h < 6; ++h) { yb_[h] = YRAW[(size_t)row * 384 + h * 64 + lane]; pv_[h] = bf2f(PV[(size_t)row * 384 + h * 64 + lane]); pg_[h] = bf2f(PG[(size_t)row * 384 + h * 64 + lane]); }
#pragma unroll
        for (int h = 0; h < 4; ++h) { oc_[h] = projf[(size_t)row * 1536 + ORAW_F + h * 64 + lane]; og_[h] = bf2f(proj[(size_t)row * NIN + PC_OG + h * 64 + lane]); }
        bonl_ = lane < 6 ? BONUS[(size_t)row * 8 + lane] : 0.f;
    };
    const float cn = p.c_norm[l * 64 + lane];
    float lng[6], lnb[6];
#pragma unroll
    for (int h = 0; h < 6; ++h) { lng[h] = p.b_ln_g[l * 384 + h * 64 + lane]; lnb[h] = p.b_ln_b[l * 384 + h * 64 + lane]; }
    if (gw < RROWS) load_row(gw, yb, pv, pg, oc, og, bonl);
    for (int row = gw; row < RROWS; row += nw) {
        float yb2[6], pv2[6], pg2[6], oc2[4], og2[4], bonl2 = 0.f;
        const bool more = row + nw < RROWS;
        if (more) load_row(row + nw, yb2, pv2, pg2, oc2, og2, bonl2);
        bf16_t* dst = row < MROWS ? proj + (size_t)row * NIN : ymeta + (size_t)(row - MROWS) * 1024;
#pragma unroll
        for (int h = 0; h < 6; ++h) {
            const int cc = h * 64 + lane;
            const float mean = sum64(yb[h]) * (1.f / 64.f);
            const float dlt = yb[h] - mean;
            const float var = sum64(dlt * dlt) * (1.f / 64.f);
            float o = dlt * rsqrtf(var + 64e-5f) * lng[h] + lnb[h];
            const float bon = __builtin_bit_cast(float, __builtin_amdgcn_readlane(__builtin_bit_cast(int, bonl), h));
            o += bon * pv[h];
            o *= pg[h];
            dst[PC_YB + cc] = f2bf(o);
        }
#pragma unroll
        for (int h = 0; h < 4; ++h) {
            const int cc = h * 64 + lane;
            const float ms = sum64(oc[h] * oc[h]) * (1.f / 64.f);
            const float r = oc[h] * rsqrtf(ms + 1e-6f) * cn * siluf_(og[h]);
            dst[PC_YC + cc] = f2bf(r);
        }
        if (more) {
#pragma unroll
            for (int h = 0; h < 6; ++h) { yb[h] = yb2[h]; pv[h] = pv2[h]; pg[h] = pg2[h]; }
#pragma unroll
            for (int h = 0; h < 4; ++h) { oc[h] = oc2[h]; og[h] = og2[h]; }
            bonl = bonl2;
        }
    }
}

#ifndef PHMASK
#define PHMASK 0x1ff
#endif
#define PHM(k) (((PHMASK) >> (k)) & 1)
#ifndef SCAN_VAR
#define SCAN_VAR 0
#endif
#ifndef PROBE_ID
#define PROBE_ID 0
#endif
#define PROBE_MULT 4
#define PRB(id, ...) do { unsigned long long _t0 = 0; if (PROBE_ID == (id)) _t0 = __builtin_amdgcn_s_memrealtime(); __VA_ARGS__; if (PROBE_ID == (id)) prb_acc += __builtin_amdgcn_s_memrealtime() - _t0; } while (0)
__global__ void __launch_bounds__(NTHREADS, 2) hymba_fwd(Params pin) {
#if defined(__HIP_DEVICE_COMPILE__)
    extern __shared__ __attribute__((aligned(16))) unsigned char shm[];
    cg::grid_group grid = cg::this_grid();
    float* ldsf = (float*)shm;
    pg8::StaticOrder S;
    unsigned long long prb_acc = 0;
    volatile LAS unsigned* xst = (volatile LAS unsigned*)(shm + LDS_BYTES);
    if (threadIdx.x == 0) { xst[0] = 0u; xst[1] = 0u; }
    if (blockIdx.x == 0) { unsigned* bw = (unsigned*)(pin.ws + WS_BAR); for (int i = threadIdx.x; i < XCD_BAR_WORDS; i += NTHREADS) bw[i] = 0u; }
    XcdBarrier xb; xb.bar = (unsigned*)(pin.ws + WS_BAR); xb.x = 0; xb.st = xst;
    typedef const __attribute__((address_space(4))) Params* KP;
    for (int ph = pin.ph_lo; ph < pin.ph_hi; ++ph) {
        KP kp = (KP)__builtin_amdgcn_kernarg_segment_ptr(); asm volatile("" : "+s"(kp));
        const Params p = *kp;
        unsigned char* ws = p.ws;
        bf16_t* WIN = (bf16_t*)(ws + WS_WIN); bf16_t* WOUT = (bf16_t*)(ws + WS_WOUT); bf16_t* WUP = (bf16_t*)(ws + WS_WUP); bf16_t* WDN = (bf16_t*)(ws + WS_WDN);
        const bool conv_in_scan = gridDim.x > 240;
        bf16_t* HB = (bf16_t*)(ws + WS_HB); bf16_t* PROJ = (bf16_t*)(ws + WS_PROJ); bf16_t* U = PROJ;
        unsigned long long* SSQ = (unsigned long long*)(ws + WS_SSQ); float* HMETA = (float*)(ws + WS_HMETA); bf16_t* YMETA = (bf16_t*)(ws + WS_YMETA);
        if (PHM(0) && ph == 0) {
            PRB(1, phase_p0(p));
            PRB(2, conv_w(ldsf, p.w_in, 1024, NIN, WIN, p.mix_norm, opaque_bid(), (int)gridDim.x));
        } else if (PHM(8) && ph == 29) {
            PRB(3, phase_final(p));
        } else {
            const int l = (ph - 1) / 7, sub = (ph - 1) % 7;
            if (PHM(1) && sub == 0) {
                EpScale<0> E{PROJ, NIN, SSQ + (size_t)(2 * l) * RROWS};
                PRB(4, meta_gemm(ldsf, HB + (size_t)MROWS * 1024, 1024, WIN, NIN, 1024, E));
                pg8::Gemm g{HB, WIN, MROWS, NIN, 1024, 1024};
                S.init(MROWS, NIN, (int)gridDim.x, (int)opaque_bid());
                PRB(5, pg8::gemm_phase<EpScale<0>, pg8::StaticOrder, false>((PG8_LAS unsigned char*)shm, g, S, E));
            } else if (PHM(2) && sub == 1) {
                if (!conv_in_scan) {
                    conv_w(ldsf, p.w_out + (size_t)l * 1024 * 1024, 1024, 1024, WOUT, nullptr, opaque_bid(), (int)gridDim.x);
                    conv_w(ldsf, p.w_up + (size_t)l * 1024 * DFF, 1024, DFF, WUP, p.ffn_norm + l * 1024, opaque_bid(), (int)gridDim.x);
                    conv_w(ldsf, p.w_down + (size_t)l * DFF * 1024, DFF, 1024, WDN, nullptr, opaque_bid(), (int)gridDim.x);
                    if (l + 1 < DEPTH) conv_w(ldsf, p.w_in + (size_t)(l + 1) * 1024 * NIN, 1024, NIN, WIN, p.mix_norm + (l + 1) * 1024, opaque_bid(), (int)gridDim.x);
                    __syncthreads();
                }
                PRB(6, phase_prep(p, shm, l));
            } else if (PHM(3) && sub == 2) {
                for (int s = opaque_bid(); s < 256; s += gridDim.x) {
                    if (s < 192) PRB(7, scan_bc<0, 0>(p, ldsf, s, l)); else if (s < 240) PRB(8, scan_a(p, shm, s - 192, l)); else PRB(14, scan_bc<0, 1>(p, ldsf, s - 240, l));
                    __syncthreads();
                }
                if (conv_in_scan && opaque_bid() >= 240) {
                    const int cw = opaque_bid() - 240, ncw = (int)gridDim.x - 240;
                    PRB(2, conv_w(ldsf, p.w_out + (size_t)l * 1024 * 1024, 1024, 1024, WOUT, nullptr, cw, ncw));
                    PRB(2, conv_w(ldsf, p.w_up + (size_t)l * 1024 * DFF, 1024, DFF, WUP, p.ffn_norm + l * 1024, cw, ncw));
                } else if (conv_in_scan && opaque_bid() >= 192) {
                    const int cw = opaque_bid() - 192, ncw = 48;
                    PRB(2, conv_w(ldsf, p.w_down + (size_t)l * DFF * 1024, DFF, 1024, WDN, nullptr, cw, ncw));
                    if (l + 1 < DEPTH) PRB(2, conv_w(ldsf, p.w_in + (size_t)(l + 1) * 1024 * NIN, 1024, NIN, WIN, p.mix_norm + (l + 1) * 1024, cw, ncw));
                }
            } else if (PHM(4) && sub == 3) {
                PRB(9, phase_post(p, l));
            } else if (PHM(5) && sub == 4) {
                EpRes E{HMETA, HB, SSQ + (size_t)(2 * l + 1) * RROWS};
                PRB(4, meta_gemm(ldsf, YMETA, 1024, WOUT, 1024, 1024, E));
                pg8::Gemm g{PROJ, WOUT, MROWS, 1024, 1024, NIN};
                S.init(MROWS, 1024, (int)gridDim.x, (int)opaque_bid());
                PRB(10, pg8::gemm_phase<EpRes, pg8::StaticOrder, false>((PG8_LAS unsigned char*)shm, g, S, E));
            } else if (PHM(6) && sub == 5) {
                EpScale<1> E{U, DFF, SSQ + (size_t)(2 * l + 1) * RROWS};
                PRB(4, meta_gemm(ldsf, HB + (size_t)MROWS * 1024, 1024, WUP, DFF, 1024, E));
                pg8::Gemm g{HB, WUP, MROWS, DFF, 1024, 1024};
                S.init(MROWS, DFF, (int)gridDim.x, (int)opaque_bid());
                PRB(11, pg8::gemm_phase<EpScale<1>, pg8::StaticOrder, false>((PG8_LAS unsigned char*)shm, g, S, E));
            } else if (PHM(7)) {
                EpRes E{HMETA, HB, SSQ + (size_t)(2 * l + 2) * RROWS};
                PRB(4, meta_gemm(ldsf, U + (size_t)MROWS * DFF, DFF, WDN, 1024, DFF, E));
                pg8::Gemm g{U, WDN, MROWS, 1024, DFF, DFF};
                S.init(MROWS, 1024, (int)gridDim.x, (int)opaque_bid());
                PRB(12, pg8::gemm_phase<EpRes, pg8::StaticOrder, false>((PG8_LAS unsigned char*)shm, g, S, E));
            }
        }
        if (ph + 1 < pin.ph_hi) { if (ph == pin.ph_lo) { PRB(13, grid.sync()); xb = xcd_barrier_post((unsigned*)(pin.ws + WS_BAR), xst); } else PRB(13, xcd_barrier(xb)); }
    }
    if (PROBE_ID != 0) { const unsigned long long t0 = __builtin_amdgcn_s_memrealtime(); while (__builtin_amdgcn_s_memrealtime() - t0 < PROBE_MULT * prb_acc) __builtin_amdgcn_s_sleep(8); }
#endif
}

extern "C" void kernel_launch(void* const* d_in, const int* in_sizes, int n_in, void* d_out, int out_size, void* d_ws, size_t ws_size, hipStream_t stream) {
    static int grid_blocks = 0;
    if (grid_blocks == 0) {
        if (n_in != 32 || ws_size < WS_END) { fprintf(stderr, "kernel_launch: unexpected n_in %d / ws_size %zu (need %zu)\n", n_in, ws_size, (size_t)WS_END); grid_blocks = -1; return; }
        int dev = 0, cus = 0, per_cu = 0;
        hipGetDevice(&dev);
        hipDeviceGetAttribute(&cus, hipDeviceAttributeMultiprocessorCount, dev);
        if (hipFuncSetAttribute((const void*)hymba_fwd, hipFuncAttributeMaxDynamicSharedMemorySize, LDS_ALLOC) != hipSuccess) { fprintf(stderr, "hipFuncSetAttribute failed\n"); grid_blocks = -1; return; }
        if (hipOccupancyMaxActiveBlocksPerMultiprocessor(&per_cu, (const void*)hymba_fwd, NTHREADS, LDS_ALLOC) != hipSuccess || per_cu < 1) { fprintf(stderr, "occupancy query failed (%d)\n", per_cu); (void)hipGetLastError(); per_cu = 1; }
        grid_blocks = cus * (per_cu > 1 ? 1 : per_cu);
        fprintf(stderr, "kernel_launch: %d CUs, %d blocks/CU by query, grid %d\n", cus, per_cu, grid_blocks);
    }
    if (grid_blocks < 0) return;
    Params p{};
    const float** pp = (const float**)&p;
    for (int i = 0; i < 32; ++i) pp[i] = (const float*)d_in[i];
    p.out = (float*)d_out; p.ws = (unsigned char*)d_ws;
#ifndef MK_PER_PHASE
    p.ph_lo = 0; p.ph_hi = 30;
    void* args[] = {&p};
    hipError_t e = hipLaunchCooperativeKernel((const void*)hymba_fwd, dim3(grid_blocks), dim3(NTHREADS), args, LDS_ALLOC, stream);
    if (e != hipSuccess) fprintf(stderr, "cooperative launch failed: %s (grid %d)\n", hipGetErrorString(e), grid_blocks);
#else
    for (int ph = 0; ph < 30; ++ph) {
        p.ph_lo = ph; p.ph_hi = ph + 1;
        hipLaunchKernelGGL(hymba_fwd, dim3(grid_blocks), dim3(NTHREADS), LDS_ALLOC, stream, p);
    }
#endif
}
```

```cpp
#include <hip/hip_runtime.h>
#include <hip/hip_cooperative_groups.h>
#include <cstdio>
namespace cg = cooperative_groups;

#define LAS __attribute__((address_space(3)))
typedef unsigned short bf16_t;
typedef short bf16x8 __attribute__((ext_vector_type(8)));
typedef float f32x4 __attribute__((ext_vector_type(4)));
typedef float f32x2 __attribute__((ext_vector_type(2)));
typedef unsigned u32x4 __attribute__((ext_vector_type(4)));
typedef unsigned u32x2 __attribute__((ext_vector_type(2)));

constexpr int D = 1024, NBATCH = 8, SEQ = 2048, NMETA = 16, LTOK = SEQ + NMETA, MROWS = NBATCH * SEQ, RROWS = MROWS + NMETA, DEPTH = 4;
constexpr int NIN = 3072, DFF = 4096, BCOLS = 1280;
constexpr int LDS_BYTES = 131072, LDS_ALLOC = LDS_BYTES + 16, NTHREADS = 512;
constexpr int PC_XA = 0, PC_GA = 384, PC_B = 768, PC_Q = 2048, PC_FZ = 2304, PC_I = 2560, PC_OG = 2816;
constexpr int PC_YA = 0, PC_YB = 384, PC_YC = 768;
constexpr size_t ACB_F = 8388608;
constexpr size_t WTL_F = 9437184;
constexpr int ORAW_F = 576;

constexpr size_t WS_WIN = 0, WS_WOUT = 6291456, WS_WUP = 8388608, WS_WDN = 16777216;
constexpr size_t WS_HB = 25165824;
constexpr size_t WS_PROJ = WS_HB + (size_t)RROWS * 1024 * 2;
constexpr size_t WS_PS = WS_PROJ + (size_t)RROWS * 3072 * 2;
constexpr size_t WS_PV = WS_PS + (size_t)RROWS * 6 * 320 * 2;
constexpr size_t WS_PG = WS_PV + (size_t)RROWS * 384 * 2;
constexpr size_t WS_VF = WS_PG + (size_t)RROWS * 384 * 2;
constexpr size_t WS_BONUS = WS_VF + (size_t)RROWS * 384 * 2;
constexpr size_t WS_SSQ = WS_BONUS + (size_t)RROWS * 8 * 4;
constexpr size_t WS_HMETA = WS_SSQ + (size_t)9 * RROWS * 8;
constexpr size_t WS_YMETA = WS_HMETA + (size_t)16 * 1024 * 4;
constexpr size_t WS_BAR = WS_YMETA + (size_t)16 * 1024 * 2;
constexpr size_t WS_END = WS_BAR + 16384;
static_assert((size_t)RROWS * 4096 * 2 <= WS_VF - WS_PROJ, "U must fit in PROJ..PG");
static_assert((size_t)RROWS * 384 * 4 <= (size_t)RROWS * 1024 * 2, "YRAW must fit in HB");
static_assert(WS_END <= 268435456ull, "workspace");

struct Params {
    const float *x, *meta, *mix_norm, *w_in, *a_conv_w, *a_conv_b, *a_w_r, *a_b_r, *a_w_i, *a_b_i, *a_lambda;
    const float *b_mu, *b_w0, *b_w2, *b_a0, *b_a2, *b_g2, *b_k_k, *b_k_a, *b_r_k, *b_ln_g, *b_ln_b, *b_v0, *b_v1, *b_v2;
    const float *c_lb, *c_norm, *w_out, *ffn_norm, *w_up, *w_down, *final_norm;
    float* out; unsigned char* ws;
    int ph_lo, ph_hi;
};

__device__ __forceinline__ int opaque_bid() { int t = blockIdx.x; asm volatile("" : "+s"(t)); return t; }
__device__ __forceinline__ int opaque_tid() { int t = threadIdx.x; asm volatile("" : "+v"(t)); return t; }
__device__ __forceinline__ unsigned cvt_pk_bf16(float lo, float hi) { unsigned r; asm volatile("v_cvt_pk_bf16_f32 %0, %1, %2" : "=v"(r) : "v"(lo), "v"(hi)); return r; }
__device__ __forceinline__ bf16_t f2bf(float f) { return (bf16_t)(cvt_pk_bf16(f, 0.f) & 0xffffu); }
__device__ __forceinline__ float bf2f(unsigned short b) { return __uint_as_float(((unsigned)b) << 16); }
__device__ __forceinline__ float bflo(unsigned u) { return __uint_as_float(u << 16); }
__device__ __forceinline__ float bfhi(unsigned u) { return __uint_as_float(u & 0xffff0000u); }
__device__ __forceinline__ float rcpf_(float x) { return __builtin_amdgcn_rcpf(x); }
__device__ __forceinline__ float sigmoidf_(float x) { return rcpf_(1.f + __expf(-x)); }
__device__ __forceinline__ float siluf_(float x) { return x * sigmoidf_(x); }
__device__ __forceinline__ float softplusf_(float x) { return fmaxf(x, 0.f) + log1pf(__expf(-fabsf(x))); }
__device__ __forceinline__ float tanhf_(float x) { const float e = __expf(-2.f * fabsf(x)); const float t = (1.f - e) * rcpf_(1.f + e); return x < 0.f ? -t : t; }
__device__ __forceinline__ float geluf_(float x) { return 0.5f * x * (1.f + tanhf_(0.7978845608028654f * (x + 0.044715f * x * x * x))); }

template <int CTRL> __device__ __forceinline__ float dppf(float x) { return __builtin_bit_cast(float, __builtin_amdgcn_update_dpp(0, __builtin_bit_cast(int, x), CTRL, 0xF, 0xF, true)); }
template <int CTRL> __device__ __forceinline__ float dppf1(float x) { return __builtin_bit_cast(float, __builtin_amdgcn_update_dpp(0x3f800000, __builtin_bit_cast(int, x), CTRL, 0xF, 0xF, false)); }
__device__ __forceinline__ float sum16(float x) {
    x += dppf<0xB1>(x); x += dppf<0x4E>(x); x += dppf<0x141>(x); x += dppf<0x140>(x); return x;
}
__device__ __forceinline__ float sum64(float x) {
    x = sum16(x);
    const int xi = __builtin_bit_cast(int, x);
    const float a = __builtin_bit_cast(float, __builtin_amdgcn_readlane(xi, 0)), b = __builtin_bit_cast(float, __builtin_amdgcn_readlane(xi, 16));
    const float c = __builtin_bit_cast(float, __builtin_amdgcn_readlane(xi, 32)), d = __builtin_bit_cast(float, __builtin_amdgcn_readlane(xi, 48));
    return (a + b) + (c + d);
}
__device__ __forceinline__ void unpack8(const u32x4 v, float* f) {
    f[0] = bflo(v.x); f[1] = bfhi(v.x); f[2] = bflo(v.y); f[3] = bfhi(v.y); f[4] = bflo(v.z); f[5] = bfhi(v.z); f[6] = bflo(v.w); f[7] = bfhi(v.w);
}
namespace pg8 {
#define PG8_LAS __attribute__((address_space(3)))
constexpr int BM = 256, BK = 64, HALF = 128, HTB = HALF * BK * 2  , STAGE_BYTES = 8 * HTB, NXCD = 8, WGM = 8;

__host__ __device__ __forceinline__ int lds_byte(int r, int c) { const int st = (r >> 4) * 2 + (c >> 5), rr = r & 15, cc = c & 31, ob = rr * 64 + cc * 2; return st * 1024 + (ob ^ (((ob >> 9) & 1) << 5)); }
__host__ __device__ __forceinline__ void stage_rc(int b, int& R, int& C) { const int st = b / 1024, sb = b % 1024, swz = sb ^ (((sb >> 9) & 1) << 5); R = (st >> 1) * 16 + swz / 64; C = (st & 1) * 32 + (swz % 64) / 2; }
__host__ __device__ __forceinline__ int perm32(int rho) { const int n = rho >> 4, i = rho & 15; return 8 * (i >> 2) + 4 * n + (i & 3); }

struct Unit { int pm, pn; };
struct Gemm { const bf16_t* A; const bf16_t* Bt; int M, N, K, lda; };

struct StaticOrder {
    int nM, nN, nwg, G, c;
    __host__ __device__ void init(int M, int N, int G_, int c_) { nM = M / BM; nN = N / BM; nwg = nM * nN; G = G_; c = c_; }
    __host__ __device__ bool next(int i, Unit& u) const {
        const long L = (long)i * G + c; if (L >= nwg) return false;
        int wgid = (int)L; { const int q = nwg / NXCD, r = nwg % NXCD, xcd = wgid % NXCD, off = wgid / NXCD; wgid = (xcd < r ? xcd * (q + 1) : r * (q + 1) + (xcd - r) * q) + off; }
        const int nig = WGM * nN, gid = wgid / nig, fm = gid * WGM, gsz = (nM - fm) < WGM ? (nM - fm) : WGM;
        u.pm = fm + ((wgid % nig) % gsz); u.pn = (wgid % nig) / gsz; return true;
    }
    __device__ __forceinline__ void a_ready(const Unit&) const {}
    __device__ __forceinline__ void done(const Unit&) const {}
};


template <class Epi, class Sched, bool AMAP>
__device__ __forceinline__ void gemm_phase(PG8_LAS unsigned char* lds, const Gemm g, const Sched& S, const Epi& E) {
    const int tid = opaque_tid(), wid = __builtin_amdgcn_readfirstlane(tid >> 6), lane = tid & 63, wr = wid >> 2, wc = wid & 3, fr = lane & 15, fq = lane >> 4;
    const int K = g.K, nt = K / BK;
    unsigned voffA[2], voffB[2];
#pragma unroll
    for (int i = 0; i < 2; ++i) { int R, C; stage_rc(tid * 16 + i * 8192, R, C); const int Rb = Epi::PERM ? ((R & ~31) + perm32(R & 31)) : R;
        voffA[i] = (unsigned)(R * g.lda + C) * 2u; voffB[i] = (unsigned)(Rb * K + C) * 2u; }
    const size_t kstep = (size_t)(BK * 2);
    const size_t hstep = (size_t)HALF * K * 2;
    const size_t tstep = 2 * hstep;
    const size_t hstepA = (size_t)HALF * g.lda * 2, tstepA = 2 * hstepA;
#define PG8_KOFS(t) ((size_t)(AMAP ? ((t) * 64 + ((t) >= 12 ? 1280 : ((t) >= 6 ? 384 : 0))) : (t) * 64) * 2)
    const unsigned ldsw = (unsigned)wid * 1024u;
    const int aoff = lds_byte(wr * 64 + fr, fq * 8), boff = lds_byte(wc * 32 + fr, fq * 8);
#define PG8_SA(b, h) (((b) * 2 + (h)) * HTB)
#define PG8_SB(b, h) ((4 + (b) * 2 + (h)) * HTB)
#define PG8_STAGE(bufoff, gbase, voff) do { _Pragma("unroll") for (int _i = 0; _i < 2; ++_i) \
        __builtin_amdgcn_global_load_lds((const unsigned*)((const char*)(gbase) + (voff)[_i]), (PG8_LAS unsigned*)(lds + (bufoff) + ldsw + _i * 8192), 16, 0, 0); } while (0)
#define PG8_LDA(dst, b, h) do { _Pragma("unroll") for (int m = 0; m < 4; ++m) _Pragma("unroll") for (int k = 0; k < 2; ++k) dst[m][k] = *(const PG8_LAS bf16x8*)(lds + PG8_SA(b, h) + aoff + m * 2048 + k * 1024); } while (0)
#define PG8_LDB(dst, b, h) do { _Pragma("unroll") for (int n = 0; n < 2; ++n) _Pragma("unroll") for (int k = 0; k < 2; ++k) dst[n][k] = *(const PG8_LAS bf16x8*)(lds + PG8_SB(b, h) + boff + n * 2048 + k * 1024); } while (0)
#define PG8_MMA(ai, bj, At, Bt) do { __builtin_amdgcn_s_setprio(1); _Pragma("unroll") for (int m = 0; m < 4; ++m) _Pragma("unroll") for (int n = 0; n < 2; ++n) _Pragma("unroll") for (int k = 0; k < 2; ++k) \
        acc[ai][bj][m][n] = __builtin_amdgcn_mfma_f32_16x16x32_bf16(Bt[n][k], At[m][k], acc[ai][bj][m][n], 0, 0, 0); __builtin_amdgcn_s_setprio(0); } while (0)
#define PG8_WAIT_V(n) asm volatile("s_waitcnt vmcnt(" #n ")" ::: "memory")
#define PG8_WAIT_L(n) asm volatile("s_waitcnt lgkmcnt(" #n ")" ::: "memory")
#define PG8_BAR __builtin_amdgcn_s_barrier()
#define PG8_SCHED __builtin_amdgcn_sched_barrier(0)
    Unit cur, nxt; int ui = 0;
    if (!S.next(0, cur)) return;
    f32x4 acc[2][2][4][2];
#pragma unroll
    for (int a = 0; a < 2; ++a)
#pragma unroll
        for (int b = 0; b < 2; ++b)
#pragma unroll
            for (int m = 0; m < 4; ++m)
#pragma unroll
                for (int n = 0; n < 2; ++n) acc[a][b][m][n] = (f32x4){0.f, 0.f, 0.f, 0.f};
    bf16x8 At[4][2], B0[2][2], B1[2][2];
    const char* cA = (const char*)g.A + (size_t)cur.pm * tstepA; const char* cB = (const char*)g.Bt + (size_t)cur.pn * tstep;
    S.a_ready(cur);
    PG8_STAGE(PG8_SB(0, 0), cB, voffB); PG8_STAGE(PG8_SA(0, 0), cA, voffA); PG8_STAGE(PG8_SB(0, 1), cB + hstep, voffB); PG8_STAGE(PG8_SA(0, 1), cA + hstepA, voffA);
    if (wr == 1) PG8_BAR;
    PG8_WAIT_V(4); PG8_BAR;
    PG8_STAGE(PG8_SB(1, 0), cB + kstep, voffB); PG8_STAGE(PG8_SA(1, 0), cA + PG8_KOFS(1), voffA); PG8_STAGE(PG8_SB(1, 1), cB + hstep + kstep, voffB);
    PG8_WAIT_V(6); PG8_BAR;
    for (;;) {
        const bool has_next = S.next(ui + 1, nxt);
        const char* nA = has_next ? (const char*)g.A + (size_t)nxt.pm * tstepA : cA; const char* nB = has_next ? (const char*)g.Bt + (size_t)nxt.pn * tstep : cB;
        for (int t = 0; t < nt; t += 2) {
            const bool last = (t == nt - 2);
            const char* a1 = cA + PG8_KOFS(t + 1);
            const char* a2 = last ? nA : cA + PG8_KOFS(t + 2); const char* b2 = last ? nB : cB + (size_t)(t + 2) * kstep;
            const char* a3 = last ? nA + PG8_KOFS(1) : cA + PG8_KOFS(t + 3); const char* b3 = b2 + kstep;
            if (last && has_next) S.a_ready(nxt);
            PG8_LDB(B0, 0, 0); PG8_SCHED; PG8_LDA(At, 0, 0); PG8_STAGE(PG8_SA(1, 1), a1 + hstepA, voffA);
            PG8_WAIT_L(8); PG8_BAR; PG8_WAIT_L(0); PG8_MMA(0, 0, At, B0); PG8_BAR; PG8_SCHED;
            PG8_LDB(B1, 0, 1); PG8_STAGE(PG8_SB(0, 0), b2, voffB);
            PG8_BAR; PG8_WAIT_L(0); PG8_MMA(0, 1, At, B1); PG8_BAR;
            PG8_LDA(At, 0, 1); PG8_STAGE(PG8_SA(0, 0), a2, voffA);
            PG8_BAR; PG8_WAIT_L(0); PG8_MMA(1, 0, At, B0); PG8_BAR; PG8_SCHED;
            PG8_STAGE(PG8_SB(0, 1), b2 + hstep, voffB);
            PG8_WAIT_V(6); PG8_BAR; PG8_MMA(1, 1, At, B1); PG8_BAR;
            PG8_LDB(B0, 1, 0); PG8_SCHED; PG8_LDA(At, 1, 0); PG8_STAGE(PG8_SA(0, 1), a2 + hstepA, voffA);
            PG8_WAIT_L(8); PG8_BAR; PG8_WAIT_L(0); PG8_MMA(0, 0, At, B0); PG8_BAR; PG8_SCHED;
            PG8_LDB(B1, 1, 1); PG8_STAGE(PG8_SB(1, 0), b3, voffB);
            PG8_BAR; PG8_WAIT_L(0); PG8_MMA(0, 1, At, B1); PG8_BAR;
            PG8_LDA(At, 1, 1); PG8_STAGE(PG8_SA(1, 0), a3, voffA);
            PG8_BAR; PG8_WAIT_L(0); PG8_MMA(1, 0, At, B0); PG8_BAR; PG8_SCHED;
            PG8_STAGE(PG8_SB(1, 1), b3 + hstep, voffB);
            PG8_WAIT_V(6); PG8_BAR; PG8_MMA(1, 1, At, B1); PG8_BAR;
        }
        if constexpr (!Epi::AFTER_DRAIN) { E(acc, cur, wr, wc, fr, fq); S.done(cur); }
        if (!has_next) break;
#pragma unroll
        for (int a = 0; a < 2; ++a)
#pragma unroll
            for (int b = 0; b < 2; ++b)
#pragma unroll
                for (int m = 0; m < 4; ++m)
#pragma unroll
                    for (int n = 0; n < 2; ++n) acc[a][b][m][n] = (f32x4){0.f, 0.f, 0.f, 0.f};
        cur = nxt; cA = nA; cB = nB; ++ui;
    }
    PG8_WAIT_V(0);
    if (wr == 0) PG8_BAR;
    PG8_BAR;
    if constexpr (Epi::AFTER_DRAIN) { E.fused(acc, cur, wr, wc, fr, fq, lds, wid, lane); S.done(cur); }
#undef PG8_SA
#undef PG8_KOFS
#undef PG8_SB
#undef PG8_STAGE
#undef PG8_LDA
#undef PG8_LDB
#undef PG8_MMA
#undef PG8_WAIT_V
#undef PG8_WAIT_L
#undef PG8_BAR
#undef PG8_SCHED
}
}


#define XB_TMO      128
#define XB_XCNT(j)  (256  + 64 * (j))
#define XB_XSUB(j)  (1280 + 64 * (j))
#define XB_XGEN(j)  (2304 + 64 * (j))
#define XB_TOP      3328
#define XB_TOPGEN   3392
#define XCD_BAR_WORDS 3456
#define XB_SPIN_CAP (1u << 18)

__device__ __forceinline__ unsigned xb_ld(unsigned* p)              { return __hip_atomic_load(p, __ATOMIC_RELAXED, __HIP_MEMORY_SCOPE_AGENT); }

__device__ __forceinline__ unsigned xb_add(unsigned* p, unsigned v) { return __hip_atomic_fetch_add(p, v, __ATOMIC_RELAXED, __HIP_MEMORY_SCOPE_AGENT); }
__device__ __forceinline__ unsigned xb_xcc_id() { return (unsigned)__builtin_amdgcn_s_getreg((3 << 11) | 20) & 0xFu; }
#define XB_SPIN(cond, bar) do { unsigned _sp = 0; while (cond) { __builtin_amdgcn_s_sleep(1); \
    if ((++_sp & 255u) == 0u) { if (xb_ld(&(bar)[XB_TMO])) break; if (_sp > XB_SPIN_CAP) { atomicAdd(&(bar)[XB_TMO], 1u); break; } } } } while (0)

struct XcdBarrier {
    unsigned* bar; unsigned x;
    volatile LAS unsigned* st;
};

__device__ __forceinline__ XcdBarrier xcd_barrier_post(unsigned* bar, volatile LAS unsigned* st) {
    XcdBarrier b; b.bar = bar; b.x = xb_xcc_id(); b.st = st;
    if (threadIdx.x == 0) (void)xb_add(&bar[XB_XCNT(b.x)], 1u);
    return b;
}
__device__ __forceinline__ void xcd_barrier_complete(unsigned* bar, unsigned x, unsigned& nloc, unsigned& nx) {
    const unsigned G = gridDim.x * gridDim.y * gridDim.z;
    unsigned sum, cnt, mine, sp = 0u;
    for (;;) {
        sum = 0u; cnt = 0u; mine = 0u;
#pragma unroll
        for (unsigned j = 0; j < 16; ++j) { const unsigned c = xb_ld(&bar[XB_XCNT(j)]); sum += c; cnt += (c > 0u) ? 1u : 0u; mine = (j == x) ? c : mine; }
        if (sum == G) break;
        __builtin_amdgcn_s_sleep(1);
        if ((++sp & 255u) == 0u) { if (xb_ld(&bar[XB_TMO])) break; if (sp > XB_SPIN_CAP) { atomicAdd(&bar[XB_TMO], 1u); break; } }
    }
    nloc = mine > 0u ? mine : 1u; nx = cnt > 0u ? cnt : 1u;
}

__device__ __forceinline__ void xcd_barrier(const XcdBarrier& b) {
    asm volatile("s_waitcnt vmcnt(0)" ::: "memory");
    __syncthreads();
    if (threadIdx.x == 0) {
        unsigned* bar = b.bar;
        __builtin_amdgcn_s_waitcnt(0);
        unsigned nloc = b.st[0], nx = b.st[1];
        if (nloc == 0u) { xcd_barrier_complete(bar, b.x, nloc, nx); b.st[0] = nloc; b.st[1] = nx; }
        const unsigned old = xb_add(&bar[XB_XSUB(b.x)], 1u);
        const unsigned gen = old / nloc;
        if (old + 1u == (gen + 1u) * nloc) {
            __builtin_amdgcn_fence(__ATOMIC_RELEASE, "agent");
            asm volatile("s_waitcnt vmcnt(0)" ::: "memory");
            const unsigned og = xb_add(&bar[XB_TOP], 1u);
            const unsigned tg = og / nx;
            if (og + 1u == (tg + 1u) * nx) xb_add(&bar[XB_TOPGEN], 1u);
            else XB_SPIN(xb_ld(&bar[XB_TOPGEN]) == tg, bar);
            __builtin_amdgcn_fence(__ATOMIC_ACQUIRE, "agent");
            xb_add(&bar[XB_XGEN(b.x)], 1u);
            asm volatile("s_waitcnt vmcnt(0)" ::: "memory");
        } else {
            XB_SPIN(xb_ld(&bar[XB_XGEN(b.x)]) == gen, bar);
            __builtin_amdgcn_fence(__ATOMIC_ACQUIRE, "agent");
            asm volatile("s_waitcnt vmcnt(0)" ::: "memory");
        }
    }
    __syncthreads();
}
constexpr float SSQ_SCALE = 16777216.f, SSQ_INV = 1.f / (16777216.f * 1024.f);
template <int ACT  > struct EpScale {
    static constexpr bool PERM = true, AFTER_DRAIN = false;
    bf16_t* O; int ldo; const unsigned long long* ssq;
    __device__ __forceinline__ u32x2 pack(f32x4 v, float rs) const {
        v = v * rs;
        if (ACT == 1) { v.x = fmaxf(v.x, 0.f); v.y = fmaxf(v.y, 0.f); v.z = fmaxf(v.z, 0.f); v.w = fmaxf(v.w, 0.f); v = v * v; }
        u32x2 o; o.x = cvt_pk_bf16(v.x, v.y); o.y = cvt_pk_bf16(v.z, v.w); return o;
    }
    __device__ __forceinline__ void operator()(const f32x4 (&acc)[2][2][4][2], const pg8::Unit& u, int wr, int wc, int fr, int fq) const {
        const int row0 = u.pm * 256 + wr * 64 + fr, col0 = u.pn * 256 + wc * 32 + 8 * fq;
        unsigned long long sq[2][4];
#pragma unroll
        for (int ai = 0; ai < 2; ++ai)
#pragma unroll
            for (int m = 0; m < 4; ++m) sq[ai][m] = ssq[row0 + ai * 128 + m * 16];
#pragma unroll
        for (int ai = 0; ai < 2; ++ai)
#pragma unroll
            for (int m = 0; m < 4; ++m) {
                const int row = row0 + ai * 128 + m * 16;
                const float rs = rsqrtf((float)sq[ai][m] * SSQ_INV + 1e-6f);
                bf16_t* rp = O + (size_t)row * ldo + col0;
#pragma unroll
                for (int bj = 0; bj < 2; ++bj) {
                    const u32x2 lo = pack(acc[ai][bj][m][0], rs), hi = pack(acc[ai][bj][m][1], rs);
                    u32x4 o; o.x = lo.x; o.y = lo.y; o.z = hi.x; o.w = hi.y;
                    *(u32x4*)(rp + bj * 128) = o;
                }
                asm volatile("" ::: "memory");
            }
    }
    __device__ __forceinline__ void meta(int m, int col, f32x4 v) const {
        const int row = MROWS + m;
        const float rs = rsqrtf((float)ssq[row] * SSQ_INV + 1e-6f);
        *(u32x2*)(O + (size_t)row * ldo + col) = pack(v, rs);
    }
};
struct EpRes {
    static constexpr bool PERM = true, AFTER_DRAIN = false;
    float* hmeta; bf16_t* hb; unsigned long long* ssq_out;
    __device__ __forceinline__ void operator()(const f32x4 (&acc)[2][2][4][2], const pg8::Unit& u, int wr, int wc, int fr, int fq) const {
        const int row0 = u.pm * 256 + wr * 64 + fr, col0 = u.pn * 256 + wc * 32 + 8 * fq;
        u32x4 hn[2];
#pragma unroll
        for (int bj = 0; bj < 2; ++bj) hn[bj] = *(const u32x4*)(hb + (size_t)row0 * 1024 + col0 + bj * 128);
#pragma unroll
        for (int g = 0; g < 8; ++g) {
            const int ai = g >> 2, m = g & 3;
            const int row = row0 + ai * 128 + m * 16;
            const size_t off = (size_t)row * 1024 + col0;
            u32x4 hc[2];
#pragma unroll
            for (int bj = 0; bj < 2; ++bj) hc[bj] = hn[bj];
            if (g < 7) {
                const int ai2 = (g + 1) >> 2, m2 = (g + 1) & 3;
                const size_t off2 = (size_t)(row0 + ai2 * 128 + m2 * 16) * 1024 + col0;
#pragma unroll
                for (int bj = 0; bj < 2; ++bj) hn[bj] = *(const u32x4*)(hb + off2 + bj * 128);
            }
            float s = 0.f;
#pragma unroll
            for (int bj = 0; bj < 2; ++bj) {
                const f32x4 r0 = {bflo(hc[bj].x), bfhi(hc[bj].x), bflo(hc[bj].y), bfhi(hc[bj].y)}, r1 = {bflo(hc[bj].z), bfhi(hc[bj].z), bflo(hc[bj].w), bfhi(hc[bj].w)};
                const f32x4 h0 = r0 + acc[ai][bj][m][0], h1 = r1 + acc[ai][bj][m][1];
                u32x4 p; p.x = cvt_pk_bf16(h0.x, h0.y); p.y = cvt_pk_bf16(h0.z, h0.w); p.z = cvt_pk_bf16(h1.x, h1.y); p.w = cvt_pk_bf16(h1.z, h1.w);
                *(u32x4*)(hb + off + bj * 128) = p;
                s += ((h0.x * h0.x + h0.y * h0.y) + (h0.z * h0.z + h0.w * h0.w)) + ((h1.x * h1.x + h1.y * h1.y) + (h1.z * h1.z + h1.w * h1.w));
            }
            s += __shfl_xor(s, 16); s += __shfl_xor(s, 32);
            if (fq == 0) atomicAdd(ssq_out + row, __float2ull_rn(s * SSQ_SCALE));
        }
    }
    __device__ __forceinline__ void meta(int m, int col, f32x4 v) const {
        float* p = hmeta + m * 1024 + col;
        f32x4 h = *(const f32x4*)p + v;
        *(f32x4*)p = h;
        u32x2 q; q.x = cvt_pk_bf16(h.x, h.y); q.y = cvt_pk_bf16(h.z, h.w);
        *(u32x2*)(hb + (size_t)(MROWS + m) * 1024 + col) = q;
        atomicAdd(ssq_out + MROWS + m, __float2ull_rn(((h.x * h.x + h.y * h.y) + (h.z * h.z + h.w * h.w)) * SSQ_SCALE));
    }
};

template <class Epi>
__device__ __forceinline__ void meta_gemm(float* red  , const bf16_t* A, int lda, const bf16_t* Bt, int N, int K, const Epi& E) {
    const int tid = opaque_tid(), wid = tid >> 6, lane = tid & 63, i16 = lane & 15, quad = lane >> 4;
    const int kper = K / 8;
    for (int tile = opaque_bid(); tile < N / 16; tile += gridDim.x) {
        f32x4 acc = {0.f, 0.f, 0.f, 0.f};
        const bf16_t* ap = A + (size_t)i16 * lda + wid * kper + quad * 8;
        const bf16_t* bp = Bt + (size_t)(tile * 16 + i16) * K + wid * kper + quad * 8;
#pragma unroll 16
        for (int k = 0; k < kper; k += 32) {
            const bf16x8 a = *(const bf16x8*)(ap + k), b = *(const bf16x8*)(bp + k);
            acc = __builtin_amdgcn_mfma_f32_16x16x32_bf16(a, b, acc, 0, 0, 0);
        }
#pragma unroll
        for (int j = 0; j < 4; ++j) red[wid * 256 + (quad * 4 + j) * 16 + i16] = acc[j];
        __syncthreads();
        if (tid < 64) {
            const int row = tid >> 2, c4 = (tid & 3) * 4;
            f32x4 s = {0.f, 0.f, 0.f, 0.f};
#pragma unroll
            for (int w = 0; w < 8; ++w) s += *(const f32x4*)(red + w * 256 + row * 16 + c4);
            E.meta(row, tile * 16 + c4, s);
        }
        __syncthreads();
    }
}

__device__ __forceinline__ void conv_w(float* lds, const float* W, int K, int N, bf16_t* WT, const float* gain, int wg, int nwg) {
    const int tid = opaque_tid(), wid = tid >> 6, lane = tid & 63;
    LAS float* scr = (LAS float*)lds + wid * (64 * 33);
    const int nblk = N / 32, nitems = (K / 64) * nblk;
    const int gw = wg * 8 + wid, nw = nwg * 8;
    for (int item = gw; item < nitems; item += nw) {
        const int kb = item / nblk, nb = item % nblk, k0 = 64 * kb, n0 = 32 * nb;
        float v[32];
#pragma unroll
        for (int i = 0; i < 32; ++i) v[i] = W[(size_t)(k0 + 2 * i + (lane >> 5)) * N + n0 + (lane & 31)];
        if (gain) {
#pragma unroll
            for (int i = 0; i < 32; ++i) v[i] *= gain[k0 + 2 * i + (lane >> 5)];
        }
#pragma unroll
        for (int i = 0; i < 32; ++i) scr[(2 * i + (lane >> 5)) * 33 + (lane & 31)] = v[i];
        __builtin_amdgcn_fence(__ATOMIC_RELEASE, "wavefront"); __builtin_amdgcn_wave_barrier(); __builtin_amdgcn_fence(__ATOMIC_ACQUIRE, "wavefront");
        const int c = lane & 7;
#pragma unroll
        for (int j = 0; j < 4; ++j) {
            const int n = (lane >> 3) + 8 * j; const LAS float* s = scr + (8 * c) * 33 + n;
            u32x4 o; o.x = cvt_pk_bf16(s[0 * 33], s[1 * 33]); o.y = cvt_pk_bf16(s[2 * 33], s[3 * 33]); o.z = cvt_pk_bf16(s[4 * 33], s[5 * 33]); o.w = cvt_pk_bf16(s[6 * 33], s[7 * 33]);
            *(u32x4*)(WT + (size_t)(n0 + n) * K + k0 + 8 * c) = o;
        }
        __builtin_amdgcn_fence(__ATOMIC_RELEASE, "wavefront"); __builtin_amdgcn_wave_barrier(); __builtin_amdgcn_fence(__ATOMIC_ACQUIRE, "wavefront");
    }
}

__device__ __forceinline__ void phase_p0(const Params& p) {
    const int tid = opaque_tid(), wid = tid >> 6, lane = tid & 63;
    const int gw = opaque_bid() * 8 + wid, nw = gridDim.x * 8;
    bf16_t* hb = (bf16_t*)(p.ws + WS_HB); unsigned long long* ssq = (unsigned long long*)(p.ws + WS_SSQ); float* hmeta = (float*)(p.ws + WS_HMETA);
    for (int i = opaque_bid() * NTHREADS + tid; i < 8 * RROWS; i += gridDim.x * NTHREADS) ssq[RROWS + i] = 0ull;
    for (int row = gw; row < RROWS; row += 2 * nw) {
        const int row2 = row + nw; const bool two = row2 < RROWS;
        const float* src = row < MROWS ? p.x + (size_t)row * 1024 : p.meta + (size_t)(row - MROWS) * 1024;
        const float* src2 = !two ? src : (row2 < MROWS ? p.x + (size_t)row2 * 1024 : p.meta + (size_t)(row2 - MROWS) * 1024);
        f32x4 v[4], w[4];
#pragma unroll
        for (int j = 0; j < 4; ++j) { v[j] = __builtin_nontemporal_load((const f32x4*)(src + j * 256 + lane * 4)); w[j] = __builtin_nontemporal_load((const f32x4*)(src2 + j * 256 + lane * 4)); }
        float s = 0.f, s2 = 0.f;
#pragma unroll
        for (int j = 0; j < 4; ++j) {
            s += (v[j].x * v[j].x + v[j].y * v[j].y) + (v[j].z * v[j].z + v[j].w * v[j].w);
            u32x2 q; q.x = cvt_pk_bf16(v[j].x, v[j].y); q.y = cvt_pk_bf16(v[j].z, v[j].w);
            *(u32x2*)(hb + (size_t)row * 1024 + j * 256 + lane * 4) = q;
            if (row >= MROWS) *(f32x4*)(hmeta + (size_t)(row - MROWS) * 1024 + j * 256 + lane * 4) = v[j];
            if (two) {
                s2 += (w[j].x * w[j].x + w[j].y * w[j].y) + (w[j].z * w[j].z + w[j].w * w[j].w);
                u32x2 q2; q2.x = cvt_pk_bf16(w[j].x, w[j].y); q2.y = cvt_pk_bf16(w[j].z, w[j].w);
                *(u32x2*)(hb + (size_t)row2 * 1024 + j * 256 + lane * 4) = q2;
                if (row2 >= MROWS) *(f32x4*)(hmeta + (size_t)(row2 - MROWS) * 1024 + j * 256 + lane * 4) = w[j];
            }
        }
        s = sum64(s); s2 = sum64(s2);
        if (lane == 0) { ssq[row] = __float2ull_rn(s * SSQ_SCALE); if (two) ssq[row2] = __float2ull_rn(s2 * SSQ_SCALE); }
    }
}
__device__ __forceinline__ void phase_final(const Params& p) {
    const int tid = opaque_tid(), wid = tid >> 6, lane = tid & 63;
    const int gw = opaque_bid() * 8 + wid, nw = gridDim.x * 8;
    const unsigned long long* ssq = (const unsigned long long*)(p.ws + WS_SSQ) + (size_t)8 * RROWS;
    f32x4 g[4];
#pragma unroll
    for (int j = 0; j < 4; ++j) g[j] = *(const f32x4*)(p.final_norm + j * 256 + lane * 4);
    const bf16_t* hb = (const bf16_t*)(p.ws + WS_HB);
    for (int row = gw; row < MROWS; row += 4 * nw) {
        u32x2 v[4][4]; float rs[4];
#pragma unroll
        for (int r = 0; r < 4; ++r) {
            const int rr = row + r * nw;
            if (rr < MROWS) {
                rs[r] = rsqrtf((float)ssq[rr] * SSQ_INV + 1e-6f);
#pragma unroll
                for (int j = 0; j < 4; ++j) v[r][j] = *(const u32x2*)(hb + (size_t)rr * 1024 + j * 256 + lane * 4);
            }
        }
#pragma unroll
        for (int r = 0; r < 4; ++r) {
            const int rr = row + r * nw;
            if (rr < MROWS) {
#pragma unroll
                for (int j = 0; j < 4; ++j) {
                    const f32x4 h = {bflo(v[r][j].x), bfhi(v[r][j].x), bflo(v[r][j].y), bfhi(v[r][j].y)};
                    __builtin_nontemporal_store(h * rs[r] * g[j], (f32x4*)(p.out + (size_t)rr * 1024 + j * 256 + lane * 4));
                }
            }
        }
    }
}
constexpr int PP_PS = 0;
constexpr int PS_LD = 1156;
constexpr int PP_ACT = PP_PS + 16 * PS_LD * 4;
constexpr int PP_VA = PP_ACT + 16 * 136 * 2;
constexpr int PP_PART = PP_VA + 16 * 392 * 2;
constexpr int PP_VLO = PP_PART + 6 * 256 * 4;
constexpr int PP_SLB = PP_VLO + 16 * 40 * 2;
constexpr int PP_CST = PP_SLB + 1024;
constexpr int PP_END = PP_CST + 6 * 384 * 4;
static_assert(PP_END <= LDS_BYTES, "prep LDS");
__device__ __forceinline__ bf16x8 ld_bfrag(const float* W, int ldw, int k0, int kmax, int c) {
    float f[8];
#pragma unroll
    for (int e = 0; e < 8; ++e) f[e] = (k0 + e) < kmax ? W[(size_t)(k0 + e) * ldw + c] : 0.f;
    u32x4 o; o.x = cvt_pk_bf16(f[0], f[1]); o.y = cvt_pk_bf16(f[2], f[3]); o.z = cvt_pk_bf16(f[4], f[5]); o.w = cvt_pk_bf16(f[6], f[7]);
    return __builtin_bit_cast(bf16x8, o);
}
__device__ __forceinline__ void phase_prep(const Params& p, unsigned char* ldsb, int l) {
    const int tid = opaque_tid();
    float* ps = (float*)(ldsb + PP_PS);
    bf16_t* act = (bf16_t*)(ldsb + PP_ACT); bf16_t* vA = (bf16_t*)(ldsb + PP_VA);
    float* part = (float*)(ldsb + PP_PART); bf16_t* vloA = (bf16_t*)(ldsb + PP_VLO); float* slb = (float*)(ldsb + PP_SLB);
    bf16_t* proj = (bf16_t*)(p.ws + WS_PROJ);
    bf16_t* PS = (bf16_t*)(p.ws + WS_PS); bf16_t* PV = (bf16_t*)(p.ws + WS_PV); bf16_t* PG = (bf16_t*)(p.ws + WS_PG); bf16_t* VF = (bf16_t*)(p.ws + WS_VF);
    float* BONUS = (float*)(p.ws + WS_BONUS);
    const float* mu = p.b_mu + l * BCOLS;
    if (tid < 256) {
        float v[4], m = -1e30f;
#pragma unroll
        for (int i = 0; i < 4; ++i) { v[i] = p.c_lb[i * 256 + tid]; m = fmaxf(m, v[i]); }
        float den = 0.f, num = 0.f;
#pragma unroll
        for (int i = 0; i < 4; ++i) { const float e = __expf(v[i] - m); den += e; if (i >= 1 && i <= l) num += e; }
        slb[tid] = num / den;
    }
    float* cst = (float*)(ldsb + PP_CST);
    for (int i = tid; i < 6 * 384; i += NTHREADS) {
        const int k = i / 384, c = i % 384;
        const float* src = k == 0 ? p.b_w0 : k == 1 ? p.b_a0 : k == 2 ? p.b_k_k : k == 3 ? p.b_k_a : k == 4 ? p.b_r_k : p.b_v0;
        cst[i] = (k == 5) ? (l > 0 ? src[(l - 1) * 384 + c] : 0.f) : src[l * 384 + c];
    }
    if (tid < 256) vloA[(tid >> 4) * 40 + 16 + (tid & 15)] = 0;
    bf16x8 Bw[4], Ba[4], Bg0[4], Bg1[4], Bv2[4], Bv1[2];
#pragma unroll
    for (int ct = 0; ct < 4; ++ct) { Bw[ct] = Ba[ct] = Bg0[ct] = Bg1[ct] = Bv2[ct] = (bf16x8){0, 0, 0, 0, 0, 0, 0, 0}; }
    Bv1[0] = Bv1[1] = (bf16x8){0, 0, 0, 0, 0, 0, 0, 0};
    const int wid0 = tid >> 6, n160 = tid & 15, quad0 = (tid >> 4) & 3;
    if (wid0 < 6) {
        const float* w2 = p.b_w2 + (size_t)l * 32 * 384; const float* a2 = p.b_a2 + (size_t)l * 32 * 384; const float* g2 = p.b_g2 + (size_t)l * 64 * 384;
#pragma unroll
        for (int ct = 0; ct < 4; ++ct) {
            const int c = wid0 * 64 + (ct >> 1) * 32 + (n160 >> 2) * 8 + (ct & 1) * 4 + (n160 & 3);
            Bw[ct] = ld_bfrag(w2, 384, quad0 * 8, 32, c); Ba[ct] = ld_bfrag(a2, 384, quad0 * 8, 32, c);
            Bg0[ct] = ld_bfrag(g2, 384, quad0 * 8, 64, c); Bg1[ct] = ld_bfrag(g2, 384, 32 + quad0 * 8, 64, c);
            if (l > 0) Bv2[ct] = ld_bfrag(p.b_v2 + (size_t)(l - 1) * 16 * 384, 384, quad0 * 8, 16, c);
        }
        if (l > 0) {
            const float* v1 = p.b_v1 + (size_t)(l - 1) * 384 * 16;
            Bv1[0] = ld_bfrag(v1, 16, wid0 * 64 + quad0 * 8, 384, n160); Bv1[1] = ld_bfrag(v1, 16, wid0 * 64 + 32 + quad0 * 8, 384, n160);
        }
    }
    __syncthreads();
    const int nmain_it = (1024 - opaque_bid() + (int)gridDim.x - 1) / (int)gridDim.x;
    for (int it = 0; it < nmain_it + (opaque_bid() < 6 ? 1 : 0); ++it) {
        const int tile = it < nmain_it ? opaque_bid() + it * (int)gridDim.x : 1024;
        const int hsel = tile == 1024 ? opaque_bid() : -1;
        const int row0 = tile * 16;
        int tidl = tid; asm volatile("" : "+v"(tidl));
        const int wid = tidl >> 6, n16 = tidl & 15, quad = (tidl >> 4) & 3;
        u32x4 cu5[5], pu5[5];
#pragma unroll
        for (int i = 0; i < 5; ++i) {
            const int q = tidl + i * NTHREADS, tok = q / 160, cc = (q % 160) * 8, row = row0 + tok;
            int prow;
            if (tile == 1024) prow = tok == 0 ? -1 : row - 1;
            else prow = (row & (SEQ - 1)) == 0 ? MROWS + NMETA - 1 : row - 1;
            cu5[i] = *(const u32x4*)(proj + (size_t)row * NIN + PC_B + cc);
            pu5[i] = (u32x4){0u, 0u, 0u, 0u};
            if (prow >= 0) pu5[i] = *(const u32x4*)(proj + (size_t)prow * NIN + PC_B + cc);
        }
#pragma unroll
        for (int i = 0; i < 5; ++i) {
            const int q = tidl + i * NTHREADS, tok = q / 160, cc = (q % 160) * 8;
            float c[8], pv[8]; unpack8(cu5[i], c); unpack8(pu5[i], pv);
            const f32x4 m0 = *(const f32x4*)(mu + cc), m1 = *(const f32x4*)(mu + cc + 4);
            float o[8];
            o[0] = c[0] + m0.x * (pv[0] - c[0]); o[1] = c[1] + m0.y * (pv[1] - c[1]); o[2] = c[2] + m0.z * (pv[2] - c[2]); o[3] = c[3] + m0.w * (pv[3] - c[3]);
            o[4] = c[4] + m1.x * (pv[4] - c[4]); o[5] = c[5] + m1.y * (pv[5] - c[5]); o[6] = c[6] + m1.z * (pv[6] - c[6]); o[7] = c[7] + m1.w * (pv[7] - c[7]);
            if (cc < 1152) {
                *(f32x4*)(ps + tok * PS_LD + cc) = (f32x4){o[0], o[1], o[2], o[3]}; *(f32x4*)(ps + tok * PS_LD + cc + 4) = (f32x4){o[4], o[5], o[6], o[7]};
                if (cc >= 768) { u32x4 b; b.x = cvt_pk_bf16(o[0], o[1]); b.y = cvt_pk_bf16(o[2], o[3]); b.z = cvt_pk_bf16(o[4], o[5]); b.w = cvt_pk_bf16(o[6], o[7]); *(u32x4*)(vA + tok * 392 + (cc - 768)) = b; }
            } else {
                if (cc < 1184) {
#pragma unroll
                    for (int e = 0; e < 8; ++e) o[e] = tanhf_(o[e]);
                } else if (cc >= 1216) {
#pragma unroll
                    for (int e = 0; e < 8; ++e) o[e] = sigmoidf_(o[e]);
                }
                u32x4 b; b.x = cvt_pk_bf16(o[0], o[1]); b.y = cvt_pk_bf16(o[2], o[3]); b.z = cvt_pk_bf16(o[4], o[5]); b.w = cvt_pk_bf16(o[6], o[7]);
                *(u32x4*)(act + tok * 136 + (cc - 1152)) = b;
            }
            asm volatile("" ::: "memory");
        }
        __syncthreads();
        if (l > 0) {
            if (wid < 6) {
                const bf16x8 a0 = *(const bf16x8*)(vA + n16 * 392 + wid * 64 + quad * 8), a1 = *(const bf16x8*)(vA + n16 * 392 + wid * 64 + 32 + quad * 8);
                f32x4 acc = {0.f, 0.f, 0.f, 0.f};
                acc = __builtin_amdgcn_mfma_f32_16x16x32_bf16(Bv1[0], a0, acc, 0, 0, 0);
                acc = __builtin_amdgcn_mfma_f32_16x16x32_bf16(Bv1[1], a1, acc, 0, 0, 0);
                *(f32x4*)(part + wid * 256 + n16 * 16 + quad * 4) = acc;
            }
            __syncthreads();
            if (tidl < 256) {
                float s = 0.f;
#pragma unroll
                for (int w = 0; w < 6; ++w) s += part[w * 256 + tidl];
                vloA[(tidl >> 4) * 40 + (tidl & 15)] = f2bf(s);
            }
            __syncthreads();
        }
        if (wid < 6 && (hsel < 0 || wid == hsel)) {
            const int h = wid, tok = n16; const unsigned row = (unsigned)(row0 + tok);
            const bf16x8 aw = *(const bf16x8*)(act + n16 * 136 + quad * 8), aa = *(const bf16x8*)(act + n16 * 136 + 32 + quad * 8);
            const bf16x8 ag0 = *(const bf16x8*)(act + n16 * 136 + 64 + quad * 8), ag1 = *(const bf16x8*)(act + n16 * 136 + 96 + quad * 8);
            const bf16x8 av = *(const bf16x8*)(vloA + n16 * 40 + quad * 8);
            float ssq = 0.f, bon = 0.f;
#pragma unroll
            for (int ct = 0; ct < 4; ++ct) {
                const int c = h * 64 + (ct >> 1) * 32 + quad * 8 + (ct & 1) * 4;
                const f32x4 kr = *(const f32x4*)(ps + tok * PS_LD + 384 + c) * *(const f32x4*)(cst + 768 + c);
                ssq += (kr.x * kr.x + kr.y * kr.y) + (kr.z * kr.z + kr.w * kr.w);
            }
            ssq += __shfl_xor(ssq, 16); ssq += __shfl_xor(ssq, 32);
            const float inv = 1.f / fmaxf(sqrtf(ssq), 1e-12f);
            u32x2 e_omw = {0u, 0u}, e_kmod = {0u, 0u}, e_rp = {0u, 0u}, e_v = {0u, 0u}, e_g = {0u, 0u}, e_kk = {0u, 0u}, e_ka = {0u, 0u};
            u32x2 vfr4[4];
#pragma unroll
            for (int ct = 0; ct < 4; ++ct) { vfr4[ct] = (u32x2){0u, 0u}; if (l > 0) vfr4[ct] = *(const u32x2*)(VF + row * 384 + h * 64 + (ct >> 1) * 32 + quad * 8 + (ct & 1) * 4); }
            bf16_t* psrow = PS + (row * 6 + h) * 256;
            float* wtl = p.out + WTL_F + ((size_t)tile * 6 + h) * 64;
#pragma unroll
            for (int ct = 0; ct < 4; ++ct) {
                int c = h * 64 + (ct >> 1) * 32 + quad * 8 + (ct & 1) * 4; asm volatile("" : "+v"(c));
                const int cl = (ct >> 1) * 32 + quad * 8;
                const f32x4 z = {0.f, 0.f, 0.f, 0.f};
                const f32x4 cw = __builtin_amdgcn_mfma_f32_16x16x32_bf16(Bw[ct], aw, z, 0, 0, 0);
                const f32x4 ca = __builtin_amdgcn_mfma_f32_16x16x32_bf16(Ba[ct], aa, z, 0, 0, 0);
                f32x4 cg = __builtin_amdgcn_mfma_f32_16x16x32_bf16(Bg0[ct], ag0, z, 0, 0, 0);
                cg = __builtin_amdgcn_mfma_f32_16x16x32_bf16(Bg1[ct], ag1, cg, 0, 0, 0);
                f32x4 cv = z;
                if (l > 0) cv = __builtin_amdgcn_mfma_f32_16x16x32_bf16(Bv2[ct], av, z, 0, 0, 0);
                const f32x4 w0 = *(const f32x4*)(cst + c), a0 = *(const f32x4*)(cst + 384 + c), kk_ = *(const f32x4*)(cst + 768 + c);
                const f32x4 ka_ = *(const f32x4*)(cst + 1152 + c), rk_ = *(const f32x4*)(cst + 1536 + c), v0 = *(const f32x4*)(cst + 1920 + c);
                const f32x4 rp = *(const f32x4*)(ps + tok * PS_LD + c), kp = *(const f32x4*)(ps + tok * PS_LD + 384 + c), vp = *(const f32x4*)(ps + tok * PS_LD + 768 + c);
                f32x4 omw, a, v = vp;
#pragma unroll
                for (int j = 0; j < 4; ++j) {
                    const float x = w0[j] + cw[j];
                    const float sp = fmaxf(-x, 0.f) + __logf(1.f + __expf(-fabsf(x)));
                    omw[j] = 1.f - __expf(-__expf(-sp - 0.5f));
                    a[j] = sigmoidf_(a0[j] + ca[j]);
                }
                if (l == 0) { u32x2 o; o.x = cvt_pk_bf16(vp.x, vp.y); o.y = cvt_pk_bf16(vp.z, vp.w); *(u32x2*)(VF + row * 384 + c) = o; }
                else {
                    const u32x2 vfr = vfr4[ct];
                    const f32x4 vf = {bflo(vfr.x), bfhi(vfr.x), bflo(vfr.y), bfhi(vfr.y)};
#pragma unroll
                    for (int j = 0; j < 4; ++j) v[j] = vp[j] + (vf[j] - vp[j]) * sigmoidf_(v0[j] + cv[j]);
                }
                const f32x4 kmod0 = kp * (1.f + (a - 1.f) * ka_);
                const f32x4 kr = kp * kk_;
                const f32x4 kk0 = kr * inv, kka0 = kk0 * a;
                const f32x4 bt = rp * kmod0 * rk_;
                bon += (bt.x + bt.y) + (bt.z + bt.w);
                f32x4 W, Wp;
#pragma unroll
                for (int j = 0; j < 4; ++j) {
                    float x = 1.f - omw[j];
                    x *= dppf1<0x111>(x); x *= dppf1<0x112>(x); x *= dppf1<0x114>(x); x *= dppf1<0x118>(x);
                    W[j] = x; Wp[j] = dppf1<0x111>(x);
                }
                f32x4 Wi; Wi.x = rcpf_(W.x); Wi.y = rcpf_(W.y); Wi.z = rcpf_(W.z); Wi.w = rcpf_(W.w);
                const f32x4 kk = kk0 * Wp, kka = kka0 * Wi, kmod = kmod0 * Wi, rps = rp * W;
                omw = W;
                u32x2 o_omw, o_kmod, o_rp, o_v, o_g, o_kk, o_ka;
                o_kk.x = cvt_pk_bf16(kk.x, kk.y); o_kk.y = cvt_pk_bf16(kk.z, kk.w); o_ka.x = cvt_pk_bf16(kka.x, kka.y); o_ka.y = cvt_pk_bf16(kka.z, kka.w);
                o_omw.x = cvt_pk_bf16(omw.x, omw.y); o_omw.y = cvt_pk_bf16(omw.z, omw.w);
                o_kmod.x = cvt_pk_bf16(kmod.x, kmod.y); o_kmod.y = cvt_pk_bf16(kmod.z, kmod.w);
                o_rp.x = cvt_pk_bf16(rps.x, rps.y); o_rp.y = cvt_pk_bf16(rps.z, rps.w);
                o_v.x = cvt_pk_bf16(v.x, v.y); o_v.y = cvt_pk_bf16(v.z, v.w);
                o_g.x = cvt_pk_bf16(cg.x, cg.y); o_g.y = cvt_pk_bf16(cg.z, cg.w);
                if (tok == 15) *(f32x4*)(wtl + cl + (ct & 1) * 4) = W;
                if ((ct & 1) == 0) { e_omw = o_omw; e_kmod = o_kmod; e_rp = o_rp; e_v = o_v; e_g = o_g; e_kk = o_kk; e_ka = o_ka; }
                else {
                    *(u32x4*)(psrow + 0 + cl) = (u32x4){e_kk.x, e_kk.y, o_kk.x, o_kk.y};
                    *(u32x4*)(psrow + 64 + cl) = (u32x4){e_ka.x, e_ka.y, o_ka.x, o_ka.y};
                    *(u32x4*)(psrow + 128 + cl) = (u32x4){e_kmod.x, e_kmod.y, o_kmod.x, o_kmod.y};
                    *(u32x4*)(psrow + 192 + cl) = (u32x4){e_rp.x, e_rp.y, o_rp.x, o_rp.y};
                    *(u32x4*)(PV + row * 384 + h * 64 + cl) = (u32x4){e_v.x, e_v.y, o_v.x, o_v.y};
                    *(u32x4*)(PG + row * 384 + h * 64 + cl) = (u32x4){e_g.x, e_g.y, o_g.x, o_g.y};
                }
                asm volatile("" ::: "memory");
                __builtin_amdgcn_sched_barrier(0);
            }
            bon += __shfl_xor(bon, 16); bon += __shfl_xor(bon, 32);
            if (quad == 0) BONUS[row * 8 + h] = bon;
        } else if (wid >= 6 && hsel <= 0) {
            const int t2 = tidl - 384, tok = t2 & 15, g = t2 >> 4;
            bf16_t* rowp = proj + (size_t)(row0 + tok) * NIN;
            float* acb = p.out + ACB_F + (size_t)tile * 256;
            u32x4 rq[4], rf[4];
#pragma unroll
            for (int i = 0; i < 4; ++i) { rq[i] = *(const u32x4*)(rowp + PC_Q + g * 32 + i * 8); rf[i] = *(const u32x4*)(rowp + PC_FZ + g * 32 + i * 8); }
#pragma unroll
            for (int i = 0; i < 4; ++i) {
                float fq_[8], ff_[8]; unpack8(rq[i], fq_); unpack8(rf[i], ff_);
#pragma unroll
                for (int e = 0; e < 8; ++e) {
                    const int c = g * 32 + i * 8 + e;
                    const float lb = slb[c];
                    const float kk = (1.f - lb) * (1.f - sigmoidf_(ff_[e]));
                    float a_ = 1.f - kk;
                    a_ *= dppf1<0x111>(a_); a_ *= dppf1<0x112>(a_); a_ *= dppf1<0x114>(a_); a_ *= dppf1<0x118>(a_);
                    a_ = fmaxf(a_, 1e-30f);
                    if (tok == 15) acb[c] = a_;
                    fq_[e] = siluf_(fq_[e]) * a_;
                    ff_[e] = kk * rcpf_(a_);
                }
                u32x4 o; o.x = cvt_pk_bf16(fq_[0], fq_[1]); o.y = cvt_pk_bf16(fq_[2], fq_[3]); o.z = cvt_pk_bf16(fq_[4], fq_[5]); o.w = cvt_pk_bf16(fq_[6], fq_[7]);
                *(u32x4*)(rowp + PC_Q + g * 32 + i * 8) = o;
                o.x = cvt_pk_bf16(ff_[0], ff_[1]); o.y = cvt_pk_bf16(ff_[2], ff_[3]); o.z = cvt_pk_bf16(ff_[4], ff_[5]); o.w = cvt_pk_bf16(ff_[6], ff_[7]);
                *(u32x4*)(rowp + PC_FZ + g * 32 + i * 8) = o;
            }
        }
        __syncthreads();
    }
}
constexpr int SB_TOK = 256, SB_BUF = 16 * SB_TOK;
constexpr int SC_TOK = 128, SC_BUF = 16 * SC_TOK;
template <int VAR, int MODE = 0>
__device__ __forceinline__ void scan_bc(const Params& p, float* lds, int slot, int l) {
    const int tid = opaque_tid(), half = tid >> 8, t2 = tid & 255, r = t2 >> 4, ks = t2 & 15;
    float* sb = lds;
    float* sv = sb + 2 * SB_BUF;
    float* sy = sv + 2 * 256;
    float* swd = sy + 2 * 256;
    float* sc = sy + 2 * 256;
    float* si = sc + 2 * SC_BUF;
    float* so = si + 2 * 256;
    float* slb = so + 2 * 256;
    const bf16_t* proj = (const bf16_t*)(p.ws + WS_PROJ);
    float* projf = (float*)(p.ws + WS_PROJ);
    const bf16_t* PS = (const bf16_t*)(p.ws + WS_PS); const bf16_t* PV = (const bf16_t*)(p.ws + WS_PV);
    float* YRAW = p.out;
    const int bb = (slot >> 2) / 6, bh = (slot >> 2) % 6, rg = slot & 3;
    const int cunit = slot * 2 + half;
    const bool hasc = (VAR == 0) && (MODE == 1) && cunit < 32;
    const int cb = cunit >> 2, ch = cunit & 3, vg = t2 >> 6, cl_ = t2 & 63, cn = cl_ & 15, cq4 = cl_ >> 4;
    bf16_t* cbase = (bf16_t*)((unsigned char*)lds + half * 45056);
    constexpr int QLD = 72, VLD = 40, CQP = 0, CKP = 16 * QLD, CIP = 2 * 16 * QLD, CKH = CIP + 64 * VLD, CIV = CKH + 64 * VLD, CAC = CIV + 64 * VLD, CB_EL = CAC + 128;
    const int ub = MODE == 0 ? bb : cb;
    if (hasc) { for (int i = t2; i < 2 * CB_EL / 8; i += 256) *(u32x4*)(cbase + i * 8) = (u32x4){0u, 0u, 0u, 0u}; }
    __syncthreads();
    u32x4 preA[3]; u32x4 prevA = {0u, 0u, 0u, 0u}; u32x4 preK[2] = {{0u, 0u, 0u, 0u}, {0u, 0u, 0u, 0u}};
    f32x4 cS[4] = {{0.f, 0.f, 0.f, 0.f}, {0.f, 0.f, 0.f, 0.f}, {0.f, 0.f, 0.f, 0.f}, {0.f, 0.f, 0.f, 0.f}};
    f32x2 Sa = {0.f, 0.f}, Sb = {0.f, 0.f};
#define SCAN_ROW(tile, tok) ((tile) == 0 ? MROWS + (tok) : ub * SEQ + ((tile) - 1) * 16 + (tok))
    auto issue = [&](int tile, u32x4 (&pre)[3], u32x4& prev_) __attribute__((always_inline)) {
        if (MODE == 0 && half == 0) {
#pragma unroll
            for (int i = 0; i < 2; ++i) { const int q = t2 + i * 256, tok = q >> 5, w = q & 31; pre[i] = *(const u32x4*)(PS + ((size_t)SCAN_ROW(tile, tok) * 6 + bh) * 256 + w * 8); }
            if (t2 < 48) {
                const int tok = t2 >> 1, h8 = t2 & 1, tgl = tile == 0 ? 1024 : bb * 128 + tile - 1;
                const void* src = t2 < 32 ? (const void*)(PV + (size_t)SCAN_ROW(tile, tok & 15) * 384 + bh * 64 + rg * 16 + h8 * 8) : (const void*)(p.out + WTL_F + ((size_t)tgl * 6 + bh) * 64 + (t2 - 32) * 4);
                prev_ = *(const u32x4*)src;
            }
        } else if (hasc) {
            const int tgl = tile == 0 ? 1024 : cb * 128 + tile - 1;
#pragma unroll
            for (int i = 0; i < 2; ++i) {
                const int q = t2 + i * 256;
                if (q < 384) {
                    const int kind = q >> 7, j = q & 127, tok = j & 15, part = j >> 4;
                    const int col = (kind == 0 ? PC_Q : (kind == 1 ? PC_FZ : PC_I)) + ch * 64 + part * 8;
                    pre[i] = *(const u32x4*)(proj + (size_t)SCAN_ROW(tile, tok) * NIN + col);
                    if (kind == 1) { const float* ac = p.out + ACB_F + (size_t)tgl * 256 + ch * 64 + part * 8; preK[0] = *(const u32x4*)ac; preK[1] = *(const u32x4*)(ac + 4); }
                } else if (q < 400) {
                    pre[i] = *(const u32x4*)(p.out + ACB_F + (size_t)tgl * 256 + ch * 64 + (q - 384) * 4);
                }
            }
        }
    };
    auto commit = [&](int buf, u32x4 (&pre)[3], u32x4& prev_) __attribute__((always_inline)) {
        if (MODE == 0 && half == 0) {
#pragma unroll
            for (int i = 0; i < 2; ++i) {
                const int q = t2 + i * 256, tok = q >> 5, w = q & 31; float f[8]; unpack8(pre[i], f);
                if (w >= 8 && w < 16) {
#pragma unroll
                    for (int e = 0; e < 8; ++e) f[e] = -f[e];
                }
                float* d = sb + buf * SB_BUF + tok * SB_TOK + w * 8;
                *(f32x4*)d = (f32x4){f[0], f[1], f[2], f[3]}; *(f32x4*)(d + 4) = (f32x4){f[4], f[5], f[6], f[7]};
            }
            if (t2 < 32) {
                const int tok = t2 >> 1, h8 = t2 & 1; float f[8]; unpack8(prev_, f);
                float* d = sv + buf * 256 + tok * 16 + h8 * 8;
                *(f32x4*)d = (f32x4){f[0], f[1], f[2], f[3]}; *(f32x4*)(d + 4) = (f32x4){f[4], f[5], f[6], f[7]};
            } else if (t2 < 48) {
                *(u32x4*)(swd + buf * 64 + (t2 - 32) * 4) = prev_;
            }
        } else if (hasc) {
            bf16_t* cb_ = cbase + buf * CB_EL;
#pragma unroll
            for (int i = 0; i < 2; ++i) {
                const int q = t2 + i * 256;
                if (q < 384) {
                    const int kind = q >> 7, j = q & 127, tok = j & 15, part = j >> 4;
                    if (kind < 2) {
                        const int kt = part >> 1, s2 = kt >> 1, e0 = (kt & 1) * 4, q0 = (part & 1) * 2;
                        bf16_t* d = cb_ + (kind == 0 ? CQP : CKP) + tok * QLD + (s2 * 4 + q0) * 8 + e0;
                        *(u32x2*)d = (u32x2){pre[i].x, pre[i].y}; *(u32x2*)(d + 8) = (u32x2){pre[i].z, pre[i].w};
                        if (kind == 1) {
                            float f[8]; unpack8(pre[i], f);
                            const f32x4 a0 = __builtin_bit_cast(f32x4, preK[0]), a1 = __builtin_bit_cast(f32x4, preK[1]);
                            const float ac[8] = {a0.x, a0.y, a0.z, a0.w, a1.x, a1.y, a1.z, a1.w};
#pragma unroll
                            for (int e = 0; e < 8; ++e) cb_[CKH + (part * 8 + e) * VLD + (tok >> 3) * 8 + (tok & 7)] = f2bf(f[e] * ac[e]);
                        }
                    } else {
                        const unsigned short h8[8] = {(unsigned short)(pre[i].x & 0xffffu), (unsigned short)(pre[i].x >> 16), (unsigned short)(pre[i].y & 0xffffu), (unsigned short)(pre[i].y >> 16),
                                                      (unsigned short)(pre[i].z & 0xffffu), (unsigned short)(pre[i].z >> 16), (unsigned short)(pre[i].w & 0xffffu), (unsigned short)(pre[i].w >> 16)};
#pragma unroll
                        for (int e = 0; e < 8; ++e) {
                            const int v = part * 8 + e;
                            cb_[CIP + v * VLD + (tok >> 2) * 8 + (tok & 3)] = h8[e];
                            cb_[CIV + v * VLD + (tok >> 3) * 8 + (tok & 7)] = h8[e];
                        }
                    }
                } else if (q < 400) {
                    *(u32x4*)(cb_ + CAC + (q - 384) * 8) = pre[i];
                }
            }
        }
    };
    issue(0, preA, prevA); commit(0, preA, prevA);
    __syncthreads();
    for (int tile = 0; tile < 129; ++tile) {
        const int buf = tile & 1;
        if (VAR != 4 && tile + 1 < 129) issue(tile + 1, preA, prevA);
        if (MODE == 0 && half == 0) {
            const float* T = sb + buf * SB_BUF + ks * 4;
            const float* V = sv + buf * 256 + r;
            f32x4 rkk[3], rka[3], rkx[3], rrr[3]; float rv[3];
            const f32x4 wend = *(const f32x4*)(swd + buf * 64 + ks * 4);
#pragma unroll
            for (int i = 0; i < 2; ++i) { const float* Tn = T + i * SB_TOK; rkk[i] = *(const f32x4*)(Tn); rka[i] = *(const f32x4*)(Tn + 64); rkx[i] = *(const f32x4*)(Tn + 128); rrr[i] = *(const f32x4*)(Tn + 192); rv[i] = V[i * 16]; }
            float ykeep = 0.f, yp = 0.f;
#pragma unroll
            for (int tok = 0; tok < 16; ++tok) {
                const int cs = tok % 3, ns = (tok + 2) % 3;
                if (tok < 14) {
                    const float* Tn = T + (tok + 2) * SB_TOK;
                    if (VAR != 3) { rkk[ns] = *(const f32x4*)(Tn); rka[ns] = *(const f32x4*)(Tn + 64); rkx[ns] = *(const f32x4*)(Tn + 128); rrr[ns] = *(const f32x4*)(Tn + 192);
                    rv[ns] = V[(tok + 2) * 16]; }
                }
                const f32x4 kk = rkk[cs], nk_ = rka[cs], kx = rkx[cs], rr = rrr[cs]; const float vv = rv[cs];
                f32x2 P = Sa * kk.xy; P = Sb * kk.zw + P;
                float d = P.x + P.y;
                const f32x2 Ta = vv * kx.xy + Sa, Tb = vv * kx.zw + Sb;
                if (VAR != 2) d = sum16(d);
                if (tok > 0) { const float y = (VAR != 2) ? sum16(yp) : yp; ykeep = (ks == tok - 1) ? y : ykeep; }
                Sa = d * nk_.xy + Ta; Sb = d * nk_.zw + Tb;
                f32x2 Q = Sa * rr.xy; Q = Sb * rr.zw + Q;
                yp = Q.x + Q.y;
            }
            { const float y = sum16(yp); ykeep = (ks == 15) ? y : ykeep; }
            Sa = Sa * wend.xy; Sb = Sb * wend.zw;
            sy[buf * 256 + ks * 16 + r] = ykeep;
        } else if (hasc) {
            const bf16_t* cb_ = cbase + buf * CB_EL;
            const bf16x8 qf0 = *(const bf16x8*)(cb_ + CQP + cn * QLD + (0 * 4 + cq4) * 8), qf1 = *(const bf16x8*)(cb_ + CQP + cn * QLD + (1 * 4 + cq4) * 8);
            const bf16x8 kf0 = *(const bf16x8*)(cb_ + CKP + cn * QLD + (0 * 4 + cq4) * 8), kf1 = *(const bf16x8*)(cb_ + CKP + cn * QLD + (1 * 4 + cq4) * 8);
            const bf16x8 ipf = *(const bf16x8*)(cb_ + CIP + (vg * 16 + cn) * VLD + cq4 * 8), ivf = *(const bf16x8*)(cb_ + CIV + (vg * 16 + cn) * VLD + cq4 * 8);
            u32x4 sp;
            sp.x = cvt_pk_bf16(cS[0].x, cS[0].y); sp.y = cvt_pk_bf16(cS[0].z, cS[0].w); sp.z = cvt_pk_bf16(cS[1].x, cS[1].y); sp.w = cvt_pk_bf16(cS[1].z, cS[1].w);
            const bf16x8 sf0 = __builtin_bit_cast(bf16x8, sp);
            sp.x = cvt_pk_bf16(cS[2].x, cS[2].y); sp.y = cvt_pk_bf16(cS[2].z, cS[2].w); sp.z = cvt_pk_bf16(cS[3].x, cS[3].y); sp.w = cvt_pk_bf16(cS[3].z, cS[3].w);
            const bf16x8 sf1 = __builtin_bit_cast(bf16x8, sp);
            f32x4 o = {0.f, 0.f, 0.f, 0.f}, att = {0.f, 0.f, 0.f, 0.f};
            o = __builtin_amdgcn_mfma_f32_16x16x32_bf16(sf0, qf0, o, 0, 0, 0);
            o = __builtin_amdgcn_mfma_f32_16x16x32_bf16(sf1, qf1, o, 0, 0, 0);
            att = __builtin_amdgcn_mfma_f32_16x16x32_bf16(kf0, qf0, att, 0, 0, 0);
            att = __builtin_amdgcn_mfma_f32_16x16x32_bf16(kf1, qf1, att, 0, 0, 0);
            att.x = (4 * cq4 + 0 <= cn) ? att.x : 0.f; att.y = (4 * cq4 + 1 <= cn) ? att.y : 0.f; att.z = (4 * cq4 + 2 <= cn) ? att.z : 0.f; att.w = (4 * cq4 + 3 <= cn) ? att.w : 0.f;
            sp.x = cvt_pk_bf16(att.x, att.y); sp.y = cvt_pk_bf16(att.z, att.w); sp.z = 0u; sp.w = 0u;
            o = __builtin_amdgcn_mfma_f32_16x16x32_bf16(ipf, __builtin_bit_cast(bf16x8, sp), o, 0, 0, 0);
            if (tile > 0 || cb == 0) *(f32x4*)(projf + (size_t)SCAN_ROW(tile, cn) * 1536 + ORAW_F + ch * 64 + vg * 16 + 4 * cq4) = o;
            const float* acs = (const float*)(cb_ + CAC);
#pragma unroll
            for (int kt = 0; kt < 4; ++kt) {
                const f32x4 ac = *(const f32x4*)(acs + 16 * kt + 4 * cq4);
                const bf16x8 khf = *(const bf16x8*)(cb_ + CKH + (16 * kt + cn) * VLD + cq4 * 8);
                cS[kt] = __builtin_amdgcn_mfma_f32_16x16x32_bf16(khf, ivf, cS[kt] * ac, 0, 0, 0);
            }
        }
        if (VAR != 4 && tile + 1 < 129) commit(buf ^ 1, preA, prevA);
        __syncthreads();
        if (VAR == 0 && MODE == 0 && half == 0 && t2 < 64 && (tile > 0 || ub == 0)) {
            const int tok = t2 >> 2, q4 = (t2 & 3) * 4, row = SCAN_ROW(tile, tok);
            if (half == 0) *(f32x4*)(YRAW + (size_t)row * 384 + bh * 64 + rg * 16 + q4) = *(const f32x4*)(sy + buf * 256 + tok * 16 + q4);
        }
    }
#undef SCAN_ROW
    __syncthreads();
}
__device__ __forceinline__ void scan_a(const Params& p, unsigned char* ldsb, int ua, int l) {
    const int tid = opaque_tid(), wid = tid >> 6, lane = tid & 63;
    const int b = ua / 6, ha = ua % 6, c0 = ha * 64;
    float* xs = (float*)ldsb;
    float* gs = xs + 67 * 64;
    float* us = gs + 64 * 64;
    float* gt = us + 64 * 64;
    float* seg = gt + 64 * 132;
    float* hc = seg + 8 * 64 * 2;
    bf16_t* ub = (bf16_t*)(hc + 128);
    bf16_t* wt = ub + 64 * 72;
    bf16_t* proj = (bf16_t*)(p.ws + WS_PROJ); bf16_t* ymeta = (bf16_t*)(p.ws + WS_YMETA);
    const int c = tid & 63, tg = tid >> 6;
    const float cw0 = p.a_conv_w[(l * 4 + 0) * 384 + c0 + c], cw1 = p.a_conv_w[(l * 4 + 1) * 384 + c0 + c], cw2 = p.a_conv_w[(l * 4 + 2) * 384 + c0 + c], cw3 = p.a_conv_w[(l * 4 + 3) * 384 + c0 + c];
    const float cbias = p.a_conv_b[l * 384 + c0 + c], br = p.a_b_r[l * 384 + c0 + c], bi = p.a_b_i[l * 384 + c0 + c];
    const float spl8 = 8.f * softplusf_(-p.a_lambda[l * 384 + c0 + c]);
    {
        const float* wr_ = p.a_w_r + ((size_t)(l * 6 + ha)) * 4096; const float* wi_ = p.a_w_i + ((size_t)(l * 6 + ha)) * 4096;
        for (int q = tid; q < 8192; q += NTHREADS) {
            const int g = q >> 12, k = (q >> 6) & 63, n = q & 63;
            wt[(g * 64 + n) * 72 + k] = f2bf(g ? wi_[k * 64 + n] : wr_[k * 64 + n]);
        }
        if (tid < 192) xs[tid] = 0.f;
        if (tid < 128) hc[tid] = 0.f;
    }
    __syncthreads();
    bf16x8 bfr[2];
    {
        const int n = lane & 15, quad = lane >> 4;
        bfr[0] = *(const bf16x8*)(wt + (wid * 16 + n) * 72 + quad * 8);
        bfr[1] = *(const bf16x8*)(wt + (wid * 16 + n) * 72 + 32 + quad * 8);
    }
    u32x4 px = {0u, 0u, 0u, 0u}, pg = {0u, 0u, 0u, 0u};
    const int ltok = tid >> 3, lc8 = (tid & 7) * 8;
#define A_ROW(tile, tok) ((tile) == 0 ? MROWS + (tok) : b * SEQ + ((tile) - 1) * 64 + (tok))
#define A_NTOK(tile) ((tile) == 0 ? 16 : 64)
    if (ltok < A_NTOK(0)) { const size_t ro = (size_t)A_ROW(0, ltok) * NIN; px = *(const u32x4*)(proj + ro + PC_XA + c0 + lc8); pg = *(const u32x4*)(proj + ro + PC_GA + c0 + lc8); }
    for (int tile = 0; tile < 33; ++tile) {
        const int ntok = A_NTOK(tile), cur = tile & 1;
        {
            float f[8]; unpack8(px, f);
            *(f32x4*)(xs + (3 + ltok) * 64 + lc8) = (f32x4){f[0], f[1], f[2], f[3]}; *(f32x4*)(xs + (3 + ltok) * 64 + lc8 + 4) = (f32x4){f[4], f[5], f[6], f[7]};
            unpack8(pg, f);
            *(f32x4*)(gs + ltok * 64 + lc8) = (f32x4){f[0], f[1], f[2], f[3]}; *(f32x4*)(gs + ltok * 64 + lc8 + 4) = (f32x4){f[4], f[5], f[6], f[7]};
        }
        __syncthreads();
        if (tile + 1 < 33 && ltok < A_NTOK(tile + 1)) { const size_t ro = (size_t)A_ROW(tile + 1, ltok) * NIN; px = *(const u32x4*)(proj + ro + PC_XA + c0 + lc8); pg = *(const u32x4*)(proj + ro + PC_GA + c0 + lc8); }
#pragma unroll
        for (int i = 0; i < 8; ++i) {
            const int tok = tg * 8 + i;
            const float u = cbias + cw0 * xs[tok * 64 + c] + cw1 * xs[(tok + 1) * 64 + c] + cw2 * xs[(tok + 2) * 64 + c] + cw3 * xs[(tok + 3) * 64 + c];
            us[tok * 64 + c] = u; ub[tok * 72 + c] = f2bf(u);
        }
        __syncthreads();
        {
            const int m = lane & 15, quad = lane >> 4;
#pragma unroll
            for (int mb = 0; mb < 4; ++mb) {
                const bf16x8 a0 = *(const bf16x8*)(ub + (mb * 16 + m) * 72 + quad * 8), a1 = *(const bf16x8*)(ub + (mb * 16 + m) * 72 + 32 + quad * 8);
                f32x4 acc = {0.f, 0.f, 0.f, 0.f};
                acc = __builtin_amdgcn_mfma_f32_16x16x32_bf16(a0, bfr[0], acc, 0, 0, 0);
                acc = __builtin_amdgcn_mfma_f32_16x16x32_bf16(a1, bfr[1], acc, 0, 0, 0);
#pragma unroll
                for (int j = 0; j < 4; ++j) gt[(mb * 16 + quad * 4 + j) * 132 + wid * 16 + m] = acc[j];
            }
        }
        __syncthreads();
        {
            float Ap = 1.f, hl = 0.f;
#pragma unroll
            for (int i = 0; i < 8; ++i) {
                const int tok = tg * 8 + i;
                float a = 1.f, dr = 0.f;
                if (tok < ntok) {
                    const float rr = sigmoidf_(gt[tok * 132 + c] + br), ii = sigmoidf_(gt[tok * 132 + 64 + c] + bi);
                    const float la = -rr * spl8;
                    a = __expf(la);
                    dr = sqrtf(fmaxf(1.f - a * a, 0.f)) * (ii * us[tok * 64 + c]);
                }
                hl = a * hl + dr; Ap *= a;
                gt[tok * 132 + c] = hl; gt[tok * 132 + 64 + c] = Ap;
            }
            seg[(tg * 64 + c) * 2] = Ap; seg[(tg * 64 + c) * 2 + 1] = hl;
        }
        float hist = 0.f;
        if (tid < 192) hist = xs[(ntok + (tid >> 6)) * 64 + c];
        __syncthreads();
        if (tid < 192) xs[(tid >> 6) * 64 + c] = hist;
        {
            float carry = hc[cur * 64 + c];
            for (int s = 0; s < tg; ++s) carry = seg[(s * 64 + c) * 2] * carry + seg[(s * 64 + c) * 2 + 1];
            float hlast = carry;
#pragma unroll
            for (int i = 0; i < 8; ++i) {
                const int tok = tg * 8 + i;
                const float h = gt[tok * 132 + c] + gt[tok * 132 + 64 + c] * carry;
                hlast = h;
                if (tok < ntok) {
                    const float y = h * geluf_(gs[tok * 64 + c]);
                    if (tile > 0) proj[(size_t)A_ROW(tile, tok) * NIN + PC_YA + c0 + c] = f2bf(y);
                    else if (b == 0) ymeta[tok * 1024 + c0 + c] = f2bf(y);
                }
            }
            if (tg == 7) hc[(cur ^ 1) * 64 + c] = hlast;
        }
        __syncthreads();
    }
#undef A_ROW
#undef A_NTOK
}
__device__ __forceinline__ void phase_post(const Params& p, int l) {
    const int tid = opaque_tid(), wid = tid >> 6, lane = tid & 63;
    const int gw = opaque_bid() * 8 + wid, nw = gridDim.x * 8;
    bf16_t* proj = (bf16_t*)(p.ws + WS_PROJ); const float* projf = (const float*)(p.ws + WS_PROJ);
    const float* YRAW = p.out;
    const bf16_t* PV = (const bf16_t*)(p.ws + WS_PV); const bf16_t* PG = (const bf16_t*)(p.ws + WS_PG);
    const float* BONUS = (const float*)(p.ws + WS_BONUS);
    bf16_t* ymeta = (bf16_t*)(p.ws + WS_YMETA);
    float yb[6], pv[6], pg[6], oc[4], og[4], bonl;
    auto load_row = [&](int row, float (&yb_)[6], float (&pv_)[6], float (&pg_)[6], float (&oc_)[4], float (&og_)[4], float& bonl_) __attribute__((always_inline)) {
#pragma unroll
        for (int h = 0; h < 6; ++h) { yb_[h] = YRAW[(size_t)row * 384 + h * 64 + lane]; pv_[h] = bf2f(PV[(size_t)row * 384 + h * 64 + lane]); pg_[h] = bf2f(PG[(size_t)row * 384 + h * 64 + lane]); }
#pragma unroll
        for (int h = 0; h < 4; ++h) { oc_[h] = projf[(size_t)row * 1536 + ORAW_F + h * 64 + lane]; og_[h] = bf2f(proj[(size_t)row * NIN + PC_OG + h * 64 + lane]); }
        bonl_ = lane < 6 ? BONUS[(size_t)row * 8 + lane] : 0.f;
    };
    const float cn = p.c_norm[l * 64 + lane];
    float lng[6], lnb[6];
#pragma unroll
    for (int h = 0; h < 6; ++h) { lng[h] = p.b_ln_g[l * 384 + h * 64 + lane]; lnb[h] = p.b_ln_b[l * 384 + h * 64 + lane]; }
    if (gw < RROWS) load_row(gw, yb, pv, pg, oc, og, bonl);
    for (int row = gw; row < RROWS; row += nw) {
        float yb2[6], pv2[6], pg2[6], oc2[4], og2[4], bonl2 = 0.f;
        const bool more = row + nw < RROWS;
        if (more) load_row(row + nw, yb2, pv2, pg2, oc2, og2, bonl2);
#pragma unroll
        for (int h = 0; h < 6; ++h) {
            const int cc = h * 64 + lane;
            const float mean = sum64(yb[h]) * (1.f / 64.f);
            const float dlt = yb[h] - mean;
            const float var = sum64(dlt * dlt) * (1.f / 64.f);
            float o = dlt * rsqrtf(var + 64e-5f) * lng[h] + lnb[h];
            const float bon = __builtin_bit_cast(float, __builtin_amdgcn_readlane(__builtin_bit_cast(int, bonl), h));
            o += bon * pv[h];
            o *= pg[h];
            if (row < MROWS) proj[(size_t)row * NIN + PC_YB + cc] = f2bf(o);
            else ymeta[(row - MROWS) * 1024 + 384 + cc] = f2bf(o);
        }
#pragma unroll
        for (int h = 0; h < 4; ++h) {
            const int cc = h * 64 + lane;
            const float ms = sum64(oc[h] * oc[h]) * (1.f / 64.f);
            const float r = oc[h] * rsqrtf(ms + 1e-6f) * cn * siluf_(og[h]);
            if (row < MROWS) proj[(size_t)row * NIN + PC_YC + cc] = f2bf(r);
            else ymeta[(row - MROWS) * 1024 + 768 + cc] = f2bf(r);
        }
        if (more) {
#pragma unroll
            for (int h = 0; h < 6; ++h) { yb[h] = yb2[h]; pv[h] = pv2[h]; pg[h] = pg2[h]; }
#pragma unroll
            for (int h = 0; h < 4; ++h) { oc[h] = oc2[h]; og[h] = og2[h]; }
            bonl = bonl2;
        }
    }
}

#ifndef PHMASK
#define PHMASK 0x1ff
#endif
#define PHM(k) (((PHMASK) >> (k)) & 1)
#ifndef SCAN_VAR
#define SCAN_VAR 0
#endif
#ifndef PROBE_ID
#define PROBE_ID 0
#endif
#define PROBE_MULT 4
#define PRB(id, ...) do { unsigned long long _t0 = 0; if (PROBE_ID == (id)) _t0 = __builtin_amdgcn_s_memrealtime(); __VA_ARGS__; if (PROBE_ID == (id)) prb_acc += __builtin_amdgcn_s_memrealtime() - _t0; } while (0)
__global__ void __launch_bounds__(NTHREADS, 2) hymba_fwd(Params pin) {
#if defined(__HIP_DEVICE_COMPILE__)
    extern __shared__ __attribute__((aligned(16))) unsigned char shm[];
    cg::grid_group grid = cg::this_grid();
    float* ldsf = (float*)shm;
    pg8::StaticOrder S;
    unsigned long long prb_acc = 0;
    volatile LAS unsigned* xst = (volatile LAS unsigned*)(shm + LDS_BYTES);
    if (threadIdx.x == 0) { xst[0] = 0u; xst[1] = 0u; }
    if (blockIdx.x == 0) { unsigned* bw = (unsigned*)(pin.ws + WS_BAR); for (int i = threadIdx.x; i < XCD_BAR_WORDS; i += NTHREADS) bw[i] = 0u; }
    XcdBarrier xb; xb.bar = (unsigned*)(pin.ws + WS_BAR); xb.x = 0; xb.st = xst;
    typedef const __attribute__((address_space(4))) Params* KP;
    for (int ph = pin.ph_lo; ph < pin.ph_hi; ++ph) {
        KP kp = (KP)__builtin_amdgcn_kernarg_segment_ptr(); asm volatile("" : "+s"(kp));
        const Params p = *kp;
        unsigned char* ws = p.ws;
        bf16_t* WIN = (bf16_t*)(ws + WS_WIN); bf16_t* WOUT = (bf16_t*)(ws + WS_WOUT); bf16_t* WUP = (bf16_t*)(ws + WS_WUP); bf16_t* WDN = (bf16_t*)(ws + WS_WDN);
        const bool conv_in_scan = gridDim.x > 240;
        bf16_t* HB = (bf16_t*)(ws + WS_HB); bf16_t* PROJ = (bf16_t*)(ws + WS_PROJ); bf16_t* U = PROJ;
        unsigned long long* SSQ = (unsigned long long*)(ws + WS_SSQ); float* HMETA = (float*)(ws + WS_HMETA); bf16_t* YMETA = (bf16_t*)(ws + WS_YMETA);
        if (PHM(0) && ph == 0) {
            PRB(1, phase_p0(p));
            PRB(2, conv_w(ldsf, p.w_in, 1024, NIN, WIN, p.mix_norm, opaque_bid(), (int)gridDim.x));
        } else if (PHM(8) && ph == 29) {
            PRB(3, phase_final(p));
        } else {
            const int l = (ph - 1) / 7, sub = (ph - 1) % 7;
            if (PHM(1) && sub == 0) {
                EpScale<0> E{PROJ, NIN, SSQ + (size_t)(2 * l) * RROWS};
                PRB(4, meta_gemm(ldsf, HB + (size_t)MROWS * 1024, 1024, WIN, NIN, 1024, E));
                pg8::Gemm g{HB, WIN, MROWS, NIN, 1024, 1024};
                S.init(MROWS, NIN, (int)gridDim.x, (int)opaque_bid());
                PRB(5, pg8::gemm_phase<EpScale<0>, pg8::StaticOrder, false>((PG8_LAS unsigned char*)shm, g, S, E));
            } else if (PHM(2) && sub == 1) {
                if (!conv_in_scan) {
                    conv_w(ldsf, p.w_out + (size_t)l * 1024 * 1024, 1024, 1024, WOUT, nullptr, opaque_bid(), (int)gridDim.x);
                    conv_w(ldsf, p.w_up + (size_t)l * 1024 * DFF, 1024, DFF, WUP, p.ffn_norm + l * 1024, opaque_bid(), (int)gridDim.x);
                    conv_w(ldsf, p.w_down + (size_t)l * DFF * 1024, DFF, 1024, WDN, nullptr, opaque_bid(), (int)gridDim.x);
                    if (l + 1 < DEPTH) conv_w(ldsf, p.w_in + (size_t)(l + 1) * 1024 * NIN, 1024, NIN, WIN, p.mix_norm + (l + 1) * 1024, opaque_bid(), (int)gridDim.x);
                    __syncthreads();
                }
                PRB(6, phase_prep(p, shm, l));
            } else if (PHM(3) && sub == 2) {
                for (int s = opaque_bid(); s < 256; s += gridDim.x) {
                    if (s < 192) PRB(7, scan_bc<0, 0>(p, ldsf, s, l)); else if (s < 240) PRB(8, scan_a(p, shm, s - 192, l)); else PRB(14, scan_bc<0, 1>(p, ldsf, s - 240, l));
                    __syncthreads();
                }
                if (conv_in_scan && opaque_bid() >= 240) {
                    const int cw = opaque_bid() - 240, ncw = (int)gridDim.x - 240;
                    PRB(2, conv_w(ldsf, p.w_out + (size_t)l * 1024 * 1024, 1024, 1024, WOUT, nullptr, cw, ncw));
                    PRB(2, conv_w(ldsf, p.w_up + (size_t)l * 1024 * DFF, 1024, DFF, WUP, p.ffn_norm + l * 1024, cw, ncw));
                } else if (conv_in_scan && opaque_bid() >= 192) {
                    const int cw = opaque_bid() - 192, ncw = 48;
                    PRB(2, conv_w(ldsf, p.w_down + (size_t)l * DFF * 1024, DFF, 1024, WDN, nullptr, cw, ncw));
                    if (l + 1 < DEPTH) PRB(2, conv_w(ldsf, p.w_in + (size_t)(l + 1) * 1024 * NIN, 1024, NIN, WIN, p.mix_norm + (l + 1) * 1024, cw, ncw));
                }
            } else if (PHM(4) && sub == 3) {
                PRB(9, phase_post(p, l));
            } else if (PHM(5) && sub == 4) {
                EpRes E{HMETA, HB, SSQ + (size_t)(2 * l + 1) * RROWS};
                PRB(4, meta_gemm(ldsf, YMETA, 1024, WOUT, 1024, 1024, E));
                pg8::Gemm g{PROJ, WOUT, MROWS, 1024, 1024, NIN};
                S.init(MROWS, 1024, (int)gridDim.x, (int)opaque_bid());
                PRB(10, pg8::gemm_phase<EpRes, pg8::StaticOrder, false>((PG8_LAS unsigned char*)shm, g, S, E));
            } else if (PHM(6) && sub == 5) {
                EpScale<1> E{U, DFF, SSQ + (size_t)(2 * l + 1) * RROWS};
                PRB(4, meta_gemm(ldsf, HB + (size_t)MROWS * 1024, 1024, WUP, DFF, 1024, E));
                pg8::Gemm g{HB, WUP, MROWS, DFF, 1024, 1024};
                S.init(MROWS, DFF, (int)gridDim.x, (int)opaque_bid());
                PRB(11, pg8::gemm_phase<EpScale<1>, pg8::StaticOrder, false>((PG8_LAS unsigned char*)shm, g, S, E));
            } else if (PHM(7)) {
                EpRes E{HMETA, HB, SSQ + (size_t)(2 * l + 2) * RROWS};
                PRB(4, meta_gemm(ldsf, U + (size_t)MROWS * DFF, DFF, WDN, 1024, DFF, E));
                pg8::Gemm g{U, WDN, MROWS, 1024, DFF, DFF};
                S.init(MROWS, 1024, (int)gridDim.x, (int)opaque_bid());
                PRB(12, pg8::gemm_phase<EpRes, pg8::StaticOrder, false>((PG8_LAS unsigned char*)shm, g, S, E));
            }
        }
        if (ph + 1 < pin.ph_hi) { if (ph == pin.ph_lo) { PRB(13, grid.sync()); xb = xcd_barrier_post((unsigned*)(pin.ws + WS_BAR), xst); } else PRB(13, xcd_barrier(xb)); }
    }
    if (PROBE_ID != 0) { const unsigned long long t0 = __builtin_amdgcn_s_memrealtime(); while (__builtin_amdgcn_s_memrealtime() - t0 < PROBE_MULT * prb_acc) __builtin_amdgcn_s_sleep(8); }
#endif
}

extern "C" void kernel_launch(void* const* d_in, const int* in_sizes, int n_in, void* d_out, int out_size, void* d_ws, size_t ws_size, hipStream_t stream) {
    static int grid_blocks = 0;
    if (grid_blocks == 0) {
        if (n_in != 32 || ws_size < WS_END) { fprintf(stderr, "kernel_launch: unexpected n_in %d / ws_size %zu (need %zu)\n", n_in, ws_size, (size_t)WS_END); grid_blocks = -1; return; }
        int dev = 0, cus = 0, per_cu = 0;
        hipGetDevice(&dev);
        hipDeviceGetAttribute(&cus, hipDeviceAttributeMultiprocessorCount, dev);
        if (hipFuncSetAttribute((const void*)hymba_fwd, hipFuncAttributeMaxDynamicSharedMemorySize, LDS_ALLOC) != hipSuccess) { fprintf(stderr, "hipFuncSetAttribute failed\n"); grid_blocks = -1; return; }
        if (hipOccupancyMaxActiveBlocksPerMultiprocessor(&per_cu, (const void*)hymba_fwd, NTHREADS, LDS_ALLOC) != hipSuccess || per_cu < 1) { fprintf(stderr, "occupancy query failed (%d)\n", per_cu); (void)hipGetLastError(); per_cu = 1; }
        grid_blocks = cus * (per_cu > 1 ? 1 : per_cu);
        fprintf(stderr, "kernel_launch: %d CUs, %d blocks/CU by query, grid %d\n", cus, per_cu, grid_blocks);
    }
    if (grid_blocks < 0) return;
    Params p{};
    const float** pp = (const float**)&p;
    for (int i = 0; i < 32; ++i) pp[i] = (const float*)d_in[i];
    p.out = (float*)d_out; p.ws = (unsigned char*)d_ws;
#ifndef MK_PER_PHASE
    p.ph_lo = 0; p.ph_hi = 30;
    void* args[] = {&p};
    hipError_t e = hipLaunchCooperativeKernel((const void*)hymba_fwd, dim3(grid_blocks), dim3(NTHREADS), args, LDS_ALLOC, stream);
    if (e != hipSuccess) fprintf(stderr, "cooperative launch failed: %s (grid %d)\n", hipGetErrorString(e), grid_blocks);
#else
    for (int ph = 0; ph < 30; ++ph) {
        p.ph_lo = ph; p.ph_hi = ph + 1;
        hipLaunchKernelGGL(hymba_fwd, dim3(grid_blocks), dim3(NTHREADS), LDS_ALLOC, stream, p);
    }
#endif
}
```
